# Optimizing an MI355X kernel written in HIP

```python
import math
import jax, jax.numpy as jnp
from jax import lax
import numpy as np

D_MODEL = 1024
BATCH = 8
SEQ = 4096
DEPTH = 1
DEC_BATCH = 32
DEC_SEQ = 2048
PAST_LEN = 128

N_HEADS = 8
HEAD_DIM = 64
V_DIM = 2 * HEAD_DIM
QK_WIDTH = 2 * N_HEADS * HEAD_DIM
ATTN_WIDTH = N_HEADS * V_DIM
ROPE_THETA = 10000.0
Q_BLOCK = 128
RMS_EPS = 1e-5
LRU_WIDTH = 1024
LRU_BLOCKS = 16
LRU_BLOCK = LRU_WIDTH // LRU_BLOCKS
LRU_C = 8.0
CONV_WIDTH = 4
CONV_LEFT = 2
GATE_WIDTH = D_MODEL
IN_WIDTH = 2 * QK_WIDTH + ATTN_WIDTH + 2 * LRU_WIDTH + 2 * GATE_WIDTH
IN_SPLITS = [QK_WIDTH, 2 * QK_WIDTH, 2 * QK_WIDTH + ATTN_WIDTH,
             2 * QK_WIDTH + ATTN_WIDTH + LRU_WIDTH,
             2 * QK_WIDTH + ATTN_WIDTH + 2 * LRU_WIDTH,
             2 * QK_WIDTH + ATTN_WIDTH + 2 * LRU_WIDTH + GATE_WIDTH]
D_FF = ((8 * D_MODEL + 3 * 256 - 1) // (3 * 256)) * 256
ALPHA = (2.0 * DEPTH) ** 0.25
BETA = (8.0 * DEPTH) ** -0.25
LN_EPS = 1e-5

kernel_name = 'hybrid_diffattn_rglru_deepnorm_encoder'


def layer_norm(x, g=None, b=None):
    xf = x.astype(jnp.float32)
    mu = jnp.mean(xf, axis=-1, keepdims=True)
    var = jnp.mean(jnp.square(xf - mu), axis=-1, keepdims=True)
    y = (xf - mu) * lax.rsqrt(var + LN_EPS)
    if g is not None:
        y = y * g.astype(jnp.float32) + b.astype(jnp.float32)
    return y.astype(x.dtype)


def rope_tables(seq):
    inv = 1.0 / (ROPE_THETA ** (jnp.arange(0, HEAD_DIM, 2, dtype=jnp.float32) / HEAD_DIM))
    ang = jnp.arange(seq, dtype=jnp.float32)[:, None] * inv[None, :]
    return jnp.cos(ang), jnp.sin(ang)


def apply_rope(t, cos, sin):
    tf = t.astype(jnp.float32)
    t1, t2 = jnp.split(tf, 2, axis=-1)
    c = cos[:, None, :]
    s = sin[:, None, :]
    return jnp.concatenate([t1 * c - t2 * s, t2 * c + t1 * s], axis=-1).astype(t.dtype)


def diff_attention(q, k, v, lam, lambda_init, subln_g):
    B, S = q.shape[0], q.shape[1]
    q = q.reshape(B, S, N_HEADS, 2, HEAD_DIM) * (HEAD_DIM ** -0.5)
    k = k.reshape(B, S, N_HEADS, 2, HEAD_DIM)
    nblk = S // Q_BLOCK
    qb = q.reshape(B, nblk, Q_BLOCK, N_HEADS, 2, HEAD_DIM).transpose(1, 0, 2, 3, 4, 5)

    def block(qi):
        s = jnp.einsum('bqhcd,bkhcd->bhcqk', qi, k).astype(jnp.float32)
        p = jax.nn.softmax(s, axis=-1)
        w = p[:, :, 0] - lam * p[:, :, 1]
        return jnp.einsum('bhqk,bkhe->bqhe', w.astype(v.dtype), v)

    o = lax.map(block, qb)
    o = o.transpose(1, 0, 2, 3, 4).reshape(B, S, N_HEADS, V_DIM)
    of = o.astype(jnp.float32)
    of = of * lax.rsqrt(jnp.mean(jnp.square(of), axis=-1, keepdims=True) + RMS_EPS)
    of = of * subln_g.astype(jnp.float32) * (1.0 - lambda_init)
    return of.reshape(B, S, ATTN_WIDTH).astype(v.dtype)


def centred_dwconv(x, w, b):
    S = x.shape[1]
    xp = jnp.pad(x, ((0, 0), (CONV_LEFT, CONV_WIDTH - 1 - CONV_LEFT), (0, 0)))
    y = b
    for tap in range(CONV_WIDTH):
        y = y + w[tap] * xp[:, tap:tap + S]
    return y


def block_diag(x, w, b):
    B, S = x.shape[0], x.shape[1]
    xb = x.reshape(B, S, LRU_BLOCKS, LRU_BLOCK)
    return jnp.einsum('bsnd,nde->bsne', xb, w).reshape(B, S, LRU_WIDTH) + b


def rg_lru(x, w_gates, b_gates, lam, reverse):
    r = jax.nn.sigmoid(block_diag(x, w_gates[0], b_gates[0]).astype(jnp.float32))
    i = jax.nn.sigmoid(block_diag(x, w_gates[1], b_gates[1]).astype(jnp.float32))
    log_a = -LRU_C * r * jax.nn.softplus(-lam.astype(jnp.float32))
    a = jnp.exp(log_a)
    drive = jnp.sqrt(-jnp.expm1(2.0 * log_a)) * (i * x.astype(jnp.float32))

    def combine(left, right):
        a1, b1 = left
        a2, b2 = right
        return a1 * a2, a2 * b1 + b2

    _, h = lax.associative_scan(combine, (a, drive), axis=1, reverse=reverse)
    return h


def encoder_layer(x, c, cos, sin, lambda_init, w_ada, b_ada, w_in, lambda_q1, lambda_k1, lambda_q2,
                  lambda_k2, subln_g, conv_w, conv_b, w_lru_gates, b_lru_gates, lru_lambda,
                  w_attn_branch, w_lru_branch, w_out, ln1_g, ln1_b, w_ffn_in, w_ffn_out, ln2_g, ln2_b):
    B, S = x.shape[0], x.shape[1]
    mod = jax.nn.silu(c) @ w_ada + b_ada
    sh1, sc1, g1, sh2, sc2, g2 = [m[:, None, :] for m in jnp.split(mod, 6, axis=-1)]

    h = layer_norm(x) * (1.0 + sc1) + sh1
    proj = h @ w_in
    q, k, v, xr, yr, ga, gl = jnp.split(proj, IN_SPLITS, axis=-1)
    q = apply_rope(q.reshape(B, S, 2 * N_HEADS, HEAD_DIM), cos, sin)
    k = apply_rope(k.reshape(B, S, 2 * N_HEADS, HEAD_DIM), cos, sin)
    v = v.reshape(B, S, N_HEADS, V_DIM)
    lam = (jnp.exp(jnp.sum(lambda_q1.astype(jnp.float32) * lambda_k1.astype(jnp.float32)))
           - jnp.exp(jnp.sum(lambda_q2.astype(jnp.float32) * lambda_k2.astype(jnp.float32)))
           + lambda_init)
    attn = diff_attention(q, k, v, lam, lambda_init, subln_g)

    xc = centred_dwconv(xr, conv_w, conv_b)
    rec = (rg_lru(xc, w_lru_gates[0], b_lru_gates[0], lru_lambda[0], False)
           + rg_lru(xc, w_lru_gates[1], b_lru_gates[1], lru_lambda[1], True))
    rec = (rec.astype(x.dtype) * jax.nn.gelu(yr))

    merged = jax.nn.sigmoid(ga) * (attn @ w_attn_branch) + jax.nn.sigmoid(gl) * (rec @ w_lru_branch)
    x = layer_norm(ALPHA * x + g1 * (merged @ w_out), ln1_g, ln1_b)

    h = layer_norm(x) * (1.0 + sc2) + sh2
    gate, up = jnp.split(h @ w_ffn_in, 2, axis=-1)
    f = (jax.nn.silu(gate) * up) @ w_ffn_out
    x = layer_norm(ALPHA * x + g2 * f, ln2_g, ln2_b)
    return x


def run_trunk(x, c, w_ada, b_ada, w_in, lambda_q1, lambda_k1, lambda_q2, lambda_k2, subln_g,
              conv_w, conv_b, w_lru_gates, b_lru_gates, lru_lambda, w_attn_branch, w_lru_branch,
              w_out, ln1_g, ln1_b, w_ffn_in, w_ffn_out, ln2_g, ln2_b):
    cos, sin = rope_tables(x.shape[1])
    for l in range(DEPTH):
        lambda_init = 0.8 - 0.6 * math.exp(-0.3 * l)
        x = encoder_layer(x, c, cos, sin, lambda_init, w_ada[l], b_ada[l], w_in[l], lambda_q1[l],
                          lambda_k1[l], lambda_q2[l], lambda_k2[l], subln_g[l], conv_w[l], conv_b[l],
                          w_lru_gates[l], b_lru_gates[l], lru_lambda[l], w_attn_branch[l],
                          w_lru_branch[l], w_out[l], ln1_g[l], ln1_b[l], w_ffn_in[l], w_ffn_out[l],
                          ln2_g[l], ln2_b[l])
    return x


def setup_inputs(seed: int = 0) -> dict:
    key = jax.random.key(seed)
    ks = jax.random.split(key, 32)
    f32 = jnp.float32
    nrm = lambda k, shape, s: jax.random.normal(k, shape, f32) * s
    u = jax.random.uniform(ks[20], (DEPTH, 2, LRU_WIDTH), f32, minval=0.9, maxval=0.999)
    a = u ** (1.0 / LRU_C)
    lru_lambda = jnp.log(a) - jnp.log1p(-a)
    return {
        'x_prompt': nrm(ks[0], (BATCH, SEQ, D_MODEL), 1.0),
        'x_sample': nrm(ks[1], (DEC_BATCH, DEC_SEQ, D_MODEL), 1.0),
        'c_prompt': nrm(ks[2], (BATCH, D_MODEL), 1.0),
        'c_sample': nrm(ks[3], (DEC_BATCH, D_MODEL), 1.0),
        'w_ada': nrm(ks[4], (DEPTH, D_MODEL, 6 * D_MODEL), D_MODEL ** -0.5 * 0.5),
        'b_ada': nrm(ks[5], (DEPTH, 6 * D_MODEL), 0.02),
        'w_in': nrm(ks[6], (DEPTH, D_MODEL, IN_WIDTH), D_MODEL ** -0.5),
        'lambda_q1': nrm(ks[7], (DEPTH, HEAD_DIM), 0.1),
        'lambda_k1': nrm(ks[8], (DEPTH, HEAD_DIM), 0.1),
        'lambda_q2': nrm(ks[9], (DEPTH, HEAD_DIM), 0.1),
        'lambda_k2': nrm(ks[10], (DEPTH, HEAD_DIM), 0.1),
        'subln_g': 1.0 + nrm(ks[11], (DEPTH, V_DIM), 0.02),
        'conv_w': nrm(ks[12], (DEPTH, CONV_WIDTH, LRU_WIDTH), CONV_WIDTH ** -0.5),
        'conv_b': nrm(ks[13], (DEPTH, LRU_WIDTH), 0.02),
        'w_lru_gates': nrm(ks[14], (DEPTH, 2, 2, LRU_BLOCKS, LRU_BLOCK, LRU_BLOCK), LRU_BLOCK ** -0.5),
        'b_lru_gates': nrm(ks[15], (DEPTH, 2, 2, LRU_WIDTH), 0.02),
        'lru_lambda': lru_lambda,
        'w_attn_branch': nrm(ks[16], (DEPTH, ATTN_WIDTH, D_MODEL), ATTN_WIDTH ** -0.5),
        'w_lru_branch': nrm(ks[17], (DEPTH, LRU_WIDTH, D_MODEL), LRU_WIDTH ** -0.5),
        'w_out': nrm(ks[18], (DEPTH, D_MODEL, D_MODEL), D_MODEL ** -0.5 * BETA),
        'ln1_g': 1.0 + nrm(ks[19], (DEPTH, D_MODEL), 0.02),
        'ln1_b': nrm(ks[21], (DEPTH, D_MODEL), 0.02),
        'w_ffn_in': nrm(ks[22], (DEPTH, D_MODEL, 2 * D_FF), D_MODEL ** -0.5),
        'w_ffn_out': nrm(ks[23], (DEPTH, D_FF, D_MODEL), D_FF ** -0.5 * BETA),
        'ln2_g': 1.0 + nrm(ks[24], (DEPTH, D_MODEL), 0.02),
        'ln2_b': nrm(ks[25], (DEPTH, D_MODEL), 0.02),
    }


def reference(x_prompt, x_sample, c_prompt, c_sample, w_ada, b_ada, w_in, lambda_q1, lambda_k1,
              lambda_q2, lambda_k2, subln_g, conv_w, conv_b, w_lru_gates, b_lru_gates, lru_lambda,
              w_attn_branch, w_lru_branch, w_out, ln1_g, ln1_b, w_ffn_in, w_ffn_out, ln2_g, ln2_b):
    y_prompt = run_trunk(x_prompt, c_prompt, w_ada, b_ada, w_in, lambda_q1, lambda_k1, lambda_q2,
                         lambda_k2, subln_g, conv_w, conv_b, w_lru_gates, b_lru_gates, lru_lambda,
                         w_attn_branch, w_lru_branch, w_out, ln1_g, ln1_b, w_ffn_in, w_ffn_out,
                         ln2_g, ln2_b)
    y_sample = run_trunk(x_sample, c_sample, w_ada, b_ada, w_in, lambda_q1, lambda_k1, lambda_q2,
                         lambda_k2, subln_g, conv_w, conv_b, w_lru_gates, b_lru_gates, lru_lambda,
                         w_attn_branch, w_lru_branch, w_out, ln1_g, ln1_b, w_ffn_in, w_ffn_out,
                         ln2_g, ln2_b)
    return (y_prompt, y_sample)
```

```cpp
#include <hip/hip_runtime.h>
#include <hip/hip_cooperative_groups.h>
#include <cstdio>
#include <cstdint>
namespace cg = cooperative_groups;

#ifndef PH_MASK
#define PH_MASK 0x1FFF
#endif
#define PHON(k) ((PH_MASK >> (k)) & 1)
#ifndef MK_MULTI
#define MK_MULTI 0
#endif

#define LAS __attribute__((address_space(3)))
typedef unsigned short bf16_t;
typedef short bf16x8 __attribute__((ext_vector_type(8)));
typedef short s16x4 __attribute__((ext_vector_type(4)));
typedef float f32x2 __attribute__((ext_vector_type(2)));
typedef float f32x4 __attribute__((ext_vector_type(4)));
typedef float f32x16 __attribute__((ext_vector_type(16)));
typedef unsigned u32x2 __attribute__((ext_vector_type(2)));
typedef unsigned u32x4 __attribute__((ext_vector_type(4)));

constexpr int DM = 1024, INW = 7168, DFF = 2816;
constexpr int M_P = 8 * 4096, M_S = 32 * 2048, M_ALL = M_P + M_S;
constexpr int CH = 32768, NCHUNK = 3;
constexpr int NMODROWS = 40;
constexpr float ALPHA = 1.189207115002721f;
constexpr float LN_EPS = 1e-5f;
constexpr float LOG2E = 1.4426950408889634f;

constexpr size_t MiB = 1u << 20;
constexpr size_t WS_WIN = 0, WS_WAB = 14 * MiB, WS_WLB = 16 * MiB, WS_WOUT = 18 * MiB, WS_WFI = 20 * MiB, WS_WFO = 31 * MiB, WS_WG = 37 * MiB;
constexpr size_t WS_MODP = 38 * MiB, WS_ROPE = 42 * MiB, WS_MISC = 43 * MiB, WS_AGG = 44 * MiB, WS_MOD = 52 * MiB;
constexpr size_t WS_H = 64 * MiB, WS_ATTN = 128 * MiB, WS_REC = 192 * MiB, WS_MRG = 256 * MiB, WS_X1 = 320 * MiB, WS_PROJ = 448 * MiB, WS_END = 896 * MiB;

constexpr int LDS_BYTES = 155648;

__device__ __forceinline__ unsigned cvt_pk_bf16(float lo, float hi) { unsigned r; asm volatile("v_cvt_pk_bf16_f32 %0, %1, %2" : "=v"(r) : "v"(lo), "v"(hi)); return r; }
__device__ __forceinline__ unsigned f2bf(float f) { unsigned u = __builtin_bit_cast(unsigned, f); return (u + 0x7fffu + ((u >> 16) & 1u)) >> 16; }
__device__ __forceinline__ float bf2f(unsigned short h) { return __uint_as_float((unsigned)h << 16); }
__device__ __forceinline__ float bflo(unsigned w) { return __uint_as_float(w << 16); }
__device__ __forceinline__ float bfhi(unsigned w) { return __uint_as_float(w & 0xffff0000u); }
__device__ __forceinline__ float fast_exp(float x) { return __builtin_amdgcn_exp2f(x * LOG2E); }
__device__ __forceinline__ float sigmoidf_(float x) { return __builtin_amdgcn_rcpf(1.0f + fast_exp(-x)); }
__device__ __forceinline__ float wave_sum(float v) {
#pragma unroll
    for (int o = 1; o < 64; o <<= 1) v += __shfl_xor(v, o);
    return v;
}
__device__ __forceinline__ int batch_of_row(int grow) { return grow < M_P ? (grow >> 12) : 8 + ((grow - M_P) >> 11); }

namespace pg8 {
constexpr int BM = 256, BK = 64, HALF = 128, HTB = HALF * BK * 2, STAGE_BYTES = 8 * HTB, NXCD = 8, WGM = 8;
__host__ __device__ __forceinline__ int lds_byte(int r, int c) { const int st = (r >> 4) * 2 + (c >> 5), rr = r & 15, cc = c & 31, ob = rr * 64 + cc * 2; return st * 1024 + (ob ^ (((ob >> 9) & 1) << 5)); }
__host__ __device__ __forceinline__ void stage_rc(int b, int& R, int& C) { const int st = b / 1024, sb = b % 1024, swz = sb ^ (((sb >> 9) & 1) << 5); R = (st >> 1) * 16 + swz / 64; C = (st & 1) * 32 + (swz % 64) / 2; }
__host__ __device__ __forceinline__ int perm32(int rho) { const int n = rho >> 4, i = rho & 15; return 8 * (i >> 2) + 4 * n + (i & 3); }

struct Unit { int pm, pn; };
struct Gemm { const bf16_t* A; const bf16_t* Bt; const bf16_t* A2; const bf16_t* Bt2; int M, N, K; };

struct StaticOrder {
    int nM, nN, nwg, G, c;
    __device__ void init(int M, int N, int G_, int c_) { nM = M / BM; nN = N / BM; nwg = nM * nN; G = G_; c = c_; }
    __device__ bool next(int i, Unit& u) const {
        const long L = (long)i * G + c; if (L >= nwg) return false;
        int wgid = (int)L; { const int q = nwg / NXCD, r = nwg % NXCD, xcd = wgid % NXCD, off = wgid / NXCD; wgid = (xcd < r ? xcd * (q + 1) : r * (q + 1) + (xcd - r) * q) + off; }
        const int nig = WGM * nN, gid = wgid / nig, fm = gid * WGM, gsz = (nM - fm) < WGM ? (nM - fm) : WGM;
        u.pm = fm + ((wgid % nig) % gsz); u.pn = (wgid % nig) / gsz; return true;
    }
};

typedef f32x4 AccT[2][2][4][2];

struct EpiProj {
    bf16_t* O; const f32x4* rope; int S;
    __device__ __forceinline__ void mid(AccT& acc, const Unit& u, int wr, int wc, int fr, int fq) const {}
    __device__ __forceinline__ void operator()(AccT& acc, const Unit& u, int wr, int wc, int fr, int fq) const {
        const int row0 = u.pm * BM + wr * 64 + fr, colt = u.pn * BM;
        if (u.pn < 8) {
            const int d0 = 16 * (wc & 1) + 4 * fq;
#pragma unroll
            for (int ai = 0; ai < 2; ++ai)
#pragma unroll
                for (int m = 0; m < 4; ++m) {
                    const int row = row0 + ai * HALF + m * 16, pos = row & (S - 1);
                    const f32x4 cs0 = rope[(pos * 32 + d0) >> 1], cs1 = rope[((pos * 32 + d0) >> 1) + 1];
                    const float c[4] = {cs0[0], cs0[2], cs1[0], cs1[2]}, s[4] = {cs0[1], cs0[3], cs1[1], cs1[3]};
#pragma unroll
                    for (int bj = 0; bj < 2; ++bj) {
                        const f32x4 t1 = acc[ai][bj][m][0], t2 = acc[ai][bj][m][1];
                        float o1[4], o2[4];
#pragma unroll
                        for (int e = 0; e < 4; ++e) { o1[e] = t1[e] * c[e] - t2[e] * s[e]; o2[e] = t2[e] * c[e] + t1[e] * s[e]; }
                        bf16_t* p = O + (size_t)row * INW + colt + bj * HALF + (wc >> 1) * 64 + d0;
                        u32x2 w1, w2; w1.x = cvt_pk_bf16(o1[0], o1[1]); w1.y = cvt_pk_bf16(o1[2], o1[3]); w2.x = cvt_pk_bf16(o2[0], o2[1]); w2.y = cvt_pk_bf16(o2[2], o2[3]);
                        *(u32x2*)p = w1; *(u32x2*)(p + 32) = w2;
                    }
                }
        } else {
            const int col0 = colt + wc * 32 + 8 * fq;
#pragma unroll
            for (int ai = 0; ai < 2; ++ai)
#pragma unroll
                for (int m = 0; m < 4; ++m) {
                    bf16_t* rowp = O + (size_t)(row0 + ai * HALF + m * 16) * INW + col0;
#pragma unroll
                    for (int bj = 0; bj < 2; ++bj) { const f32x4 v0 = acc[ai][bj][m][0], v1 = acc[ai][bj][m][1];
                        u32x4 w; w.x = cvt_pk_bf16(v0[0], v0[1]); w.y = cvt_pk_bf16(v0[2], v0[3]); w.z = cvt_pk_bf16(v1[0], v1[1]); w.w = cvt_pk_bf16(v1[2], v1[3]);
                        *(u32x4*)(rowp + bj * HALF) = w; }
                }
        }
    }
};

struct EpiMerge {
    bf16_t* O; const bf16_t* P;
    __device__ __forceinline__ void mid(AccT& acc, const Unit& u, int wr, int wc, int fr, int fq) const {
        const int row0 = u.pm * BM + wr * 64 + fr, col0 = u.pn * BM + wc * 32 + 8 * fq;
#pragma unroll
        for (int ai = 0; ai < 2; ++ai)
#pragma unroll
            for (int m = 0; m < 4; ++m) {
                const bf16_t* rp = P + (size_t)(row0 + ai * HALF + m * 16) * INW + col0;
#pragma unroll
                for (int bj = 0; bj < 2; ++bj) {
                    const u32x4 ga = *(const u32x4*)(rp + 5120 + bj * HALF), gl = *(const u32x4*)(rp + 6144 + bj * HALF);
#pragma unroll
                    for (int q = 0; q < 4; ++q) {
                        const float a0 = bflo(ga[q]), a1 = bfhi(ga[q]), l0 = bflo(gl[q]), l1 = bfhi(gl[q]);
                        const float r0 = (1.0f + fast_exp(-l0)) * __builtin_amdgcn_rcpf(1.0f + fast_exp(-a0));
                        const float r1 = (1.0f + fast_exp(-l1)) * __builtin_amdgcn_rcpf(1.0f + fast_exp(-a1));
                        acc[ai][bj][m][q >> 1][(q & 1) * 2 + 0] *= r0; acc[ai][bj][m][q >> 1][(q & 1) * 2 + 1] *= r1;
                    }
                }
            }
    }
    __device__ __forceinline__ void operator()(AccT& acc, const Unit& u, int wr, int wc, int fr, int fq) const {
        const int row0 = u.pm * BM + wr * 64 + fr, col0 = u.pn * BM + wc * 32 + 8 * fq;
#pragma unroll
        for (int ai = 0; ai < 2; ++ai)
#pragma unroll
            for (int m = 0; m < 4; ++m) {
                const size_t row = (size_t)(row0 + ai * HALF + m * 16);
                const bf16_t* rp = P + row * INW + col0;
#pragma unroll
                for (int bj = 0; bj < 2; ++bj) {
                    const u32x4 gl = *(const u32x4*)(rp + 6144 + bj * HALF);
                    float v[8];
#pragma unroll
                    for (int q = 0; q < 4; ++q) {
                        v[2 * q] = acc[ai][bj][m][q >> 1][(q & 1) * 2 + 0] * sigmoidf_(bflo(gl[q]));
                        v[2 * q + 1] = acc[ai][bj][m][q >> 1][(q & 1) * 2 + 1] * sigmoidf_(bfhi(gl[q]));
                    }
                    u32x4 w; w.x = cvt_pk_bf16(v[0], v[1]); w.y = cvt_pk_bf16(v[2], v[3]); w.z = cvt_pk_bf16(v[4], v[5]); w.w = cvt_pk_bf16(v[6], v[7]);
                    *(u32x4*)(O + row * DM + col0 + bj * HALF) = w;
                }
            }
    }
};

struct EpiRes {
    const float* base; float* Y; const float* gate  ; int S, b0;
    __device__ __forceinline__ void mid(AccT& acc, const Unit& u, int wr, int wc, int fr, int fq) const {}
    __device__ __forceinline__ void operator()(AccT& acc, const Unit& u, int wr, int wc, int fr, int fq) const {
        const int row0 = u.pm * BM + wr * 64 + fr, col0 = u.pn * BM + wc * 32 + 8 * fq;
        const float* gp = gate + (size_t)(b0 + (u.pm * BM) / S) * 6144 + col0;
        f32x4 gv[2][2];
#pragma unroll
        for (int bj = 0; bj < 2; ++bj)
#pragma unroll
            for (int n = 0; n < 2; ++n) gv[bj][n] = *(const f32x4*)(gp + bj * HALF + 4 * n);
#pragma unroll
        for (int ai = 0; ai < 2; ++ai)
#pragma unroll
            for (int m = 0; m < 4; ++m) {
                const size_t off = (size_t)(row0 + ai * HALF + m * 16) * DM + col0;
#pragma unroll
                for (int bj = 0; bj < 2; ++bj)
#pragma unroll
                    for (int n = 0; n < 2; ++n) {
                        const f32x4 x = *(const f32x4*)(base + off + bj * HALF + 4 * n);
                        *(f32x4*)(Y + off + bj * HALF + 4 * n) = x * ALPHA + gv[bj][n] * acc[ai][bj][m][n];
                    }
            }
    }
};

struct EpiSwiGLU {
    bf16_t* O;
    __device__ __forceinline__ void mid(AccT& acc, const Unit& u, int wr, int wc, int fr, int fq) const {}
    __device__ __forceinline__ void operator()(AccT& acc, const Unit& u, int wr, int wc, int fr, int fq) const {
        const int row0 = u.pm * BM + wr * 64 + fr, col0 = u.pn * 128 + wc * 16 + 4 * fq;
#pragma unroll
        for (int ai = 0; ai < 2; ++ai)
#pragma unroll
            for (int m = 0; m < 4; ++m) {
                bf16_t* rowp = O + (size_t)(row0 + ai * HALF + m * 16) * DFF + col0;
#pragma unroll
                for (int bj = 0; bj < 2; ++bj) {
                    const f32x4 g = acc[ai][bj][m][0], up = acc[ai][bj][m][1];
                    float v[4];
#pragma unroll
                    for (int e = 0; e < 4; ++e) v[e] = g[e] * sigmoidf_(g[e]) * up[e];
                    u32x2 w; w.x = cvt_pk_bf16(v[0], v[1]); w.y = cvt_pk_bf16(v[2], v[3]);
                    *(u32x2*)(rowp + bj * 64) = w;
                }
            }
    }
};

template <class Epi, bool DUAL>
__device__ __forceinline__ void gemm_phase(LAS unsigned char* lds, const Gemm g, const StaticOrder& S, const Epi& E) {
    int tid = threadIdx.x; asm volatile("" : "+v"(tid));
    const int wid = __builtin_amdgcn_readfirstlane(tid >> 6), lane = tid & 63, wr = wid >> 2, wc = wid & 3, fr = lane & 15, fq = lane >> 4;
    const int K = g.K, nt = K / BK;
    unsigned voffA[2], voffB[2];
#pragma unroll
    for (int i = 0; i < 2; ++i) { int R, C; stage_rc(tid * 16 + i * 8192, R, C); const int Rb = (R & ~31) + perm32(R & 31);
        voffA[i] = (unsigned)(R * K + C) * 2u; voffB[i] = (unsigned)(Rb * K + C) * 2u; }
    const size_t kstep = (size_t)(BK * 2);
    const size_t hstep = (size_t)HALF * K * 2;
    const size_t tstep = 2 * hstep;
    const unsigned ldsw = (unsigned)wid * 1024u;
    const int aoff = lds_byte(wr * 64 + fr, fq * 8), boff = lds_byte(wc * 32 + fr, fq * 8);
#define PG8_SA(b, h) (((b) * 2 + (h)) * HTB)
#define PG8_SB(b, h) ((4 + (b) * 2 + (h)) * HTB)
#define PG8_STAGE(bufoff, gbase, voff) do { _Pragma("unroll") for (int _i = 0; _i < 2; ++_i) \
        __builtin_amdgcn_global_load_lds((const unsigned*)((const char*)(gbase) + (voff)[_i]), (LAS unsigned*)(lds + (bufoff) + ldsw + _i * 8192), 16, 0, 0); } while (0)
#define PG8_LDA(dst, b, h) do { _Pragma("unroll") for (int m = 0; m < 4; ++m) _Pragma("unroll") for (int k = 0; k < 2; ++k) dst[m][k] = *(const LAS bf16x8*)(lds + PG8_SA(b, h) + aoff + m * 2048 + k * 1024); } while (0)
#define PG8_LDB(dst, b, h) do { _Pragma("unroll") for (int n = 0; n < 2; ++n) _Pragma("unroll") for (int k = 0; k < 2; ++k) dst[n][k] = *(const LAS bf16x8*)(lds + PG8_SB(b, h) + boff + n * 2048 + k * 1024); } while (0)
#define PG8_MMA(ai, bj, At, Bt) do { __builtin_amdgcn_s_setprio(1); _Pragma("unroll") for (int m = 0; m < 4; ++m) _Pragma("unroll") for (int n = 0; n < 2; ++n) _Pragma("unroll") for (int k = 0; k < 2; ++k) \
        acc[ai][bj][m][n] = __builtin_amdgcn_mfma_f32_16x16x32_bf16(Bt[n][k], At[m][k], acc[ai][bj][m][n], 0, 0, 0); __builtin_amdgcn_s_setprio(0); } while (0)
#define PG8_WAIT_V(n) asm volatile("s_waitcnt vmcnt(" #n ")" ::: "memory")
#define PG8_WAIT_L(n) asm volatile("s_waitcnt lgkmcnt(" #n ")" ::: "memory")
#define PG8_BAR __builtin_amdgcn_s_barrier()
#define PG8_SCHED __builtin_amdgcn_sched_barrier(0)
#define PG8_GETU(ui_, u_, part_, ok_) do { if (DUAL) { ok_ = S.next((ui_) >> 1, u_); part_ = (ui_) & 1; } else { ok_ = S.next((ui_), u_); part_ = 0; } } while (0)
    Unit cur, nxt; int ui = 0, cpart = 0, npart = 0; bool ok;
    PG8_GETU(0, cur, cpart, ok);
    if (!ok) return;
    AccT acc;
#pragma unroll
    for (int a = 0; a < 2; ++a)
#pragma unroll
        for (int b = 0; b < 2; ++b)
#pragma unroll
            for (int m = 0; m < 4; ++m)
#pragma unroll
                for (int n = 0; n < 2; ++n) acc[a][b][m][n] = (f32x4){0.f, 0.f, 0.f, 0.f};
    bf16x8 At[4][2], B0[2][2], B1[2][2];
    const char* cA = (const char*)(cpart ? g.A2 : g.A) + (size_t)cur.pm * tstep; const char* cB = (const char*)(cpart ? g.Bt2 : g.Bt) + (size_t)cur.pn * tstep;
    PG8_STAGE(PG8_SB(0, 0), cB, voffB); PG8_STAGE(PG8_SB(0, 1), cB + hstep, voffB); PG8_STAGE(PG8_SA(0, 0), cA, voffA); PG8_STAGE(PG8_SA(0, 1), cA + hstep, voffA);
    if (wr == 1) PG8_BAR;
    PG8_WAIT_V(2); PG8_BAR;
    PG8_STAGE(PG8_SB(1, 0), cB + kstep, voffB); PG8_STAGE(PG8_SA(1, 0), cA + kstep, voffA); PG8_STAGE(PG8_SB(1, 1), cB + hstep + kstep, voffB);
    PG8_WAIT_V(6); PG8_BAR;
    for (;;) {
        bool has_next; PG8_GETU(ui + 1, nxt, npart, has_next);
        const char* nA = has_next ? (const char*)(npart ? g.A2 : g.A) + (size_t)nxt.pm * tstep : cA; const char* nB = has_next ? (const char*)(npart ? g.Bt2 : g.Bt) + (size_t)nxt.pn * tstep : cB;
        for (int t = 0; t < nt; t += 2) {
            const bool last = (t == nt - 2);
            const char* a1 = cA + (size_t)(t + 1) * kstep;
            const char* a2 = last ? nA : cA + (size_t)(t + 2) * kstep; const char* b2 = last ? nB : cB + (size_t)(t + 2) * kstep;
            const char* a3 = a2 + kstep; const char* b3 = b2 + kstep;
            PG8_LDB(B0, 0, 0); PG8_LDB(B1, 0, 1); PG8_SCHED; PG8_LDA(At, 0, 0); PG8_STAGE(PG8_SA(1, 1), a1 + hstep, voffA);
            PG8_WAIT_V(8); PG8_WAIT_L(0); PG8_BAR; PG8_MMA(0, 0, At, B0); PG8_MMA(0, 1, At, B1); PG8_BAR; PG8_SCHED;
            PG8_LDA(At, 0, 1); PG8_STAGE(PG8_SB(0, 0), b2, voffB); PG8_STAGE(PG8_SB(0, 1), b2 + hstep, voffB); PG8_STAGE(PG8_SA(0, 0), a2, voffA);
            PG8_WAIT_V(8); PG8_WAIT_L(0); PG8_BAR; PG8_MMA(1, 0, At, B0); PG8_MMA(1, 1, At, B1); PG8_BAR; PG8_SCHED;
            PG8_LDB(B0, 1, 0); PG8_LDB(B1, 1, 1); PG8_SCHED; PG8_LDA(At, 1, 0); PG8_STAGE(PG8_SA(0, 1), a2 + hstep, voffA);
            PG8_WAIT_V(8); PG8_WAIT_L(0); PG8_BAR; PG8_MMA(0, 0, At, B0); PG8_MMA(0, 1, At, B1); PG8_BAR; PG8_SCHED;
            PG8_LDA(At, 1, 1); PG8_STAGE(PG8_SB(1, 0), b3, voffB); PG8_STAGE(PG8_SB(1, 1), b3 + hstep, voffB); PG8_STAGE(PG8_SA(1, 0), a3, voffA);
            PG8_WAIT_V(8); PG8_WAIT_L(0); PG8_BAR; PG8_MMA(1, 0, At, B0); PG8_MMA(1, 1, At, B1); PG8_BAR; PG8_SCHED;
        }
        if (wr == 0) PG8_BAR;
        const bool midpart = DUAL && (cpart == 0);
        if (midpart) E.mid(acc, cur, wr, wc, fr, fq); else E(acc, cur, wr, wc, fr, fq);
        if (!has_next) break;
        if (!midpart) {
#pragma unroll
            for (int a = 0; a < 2; ++a)
#pragma unroll
                for (int b = 0; b < 2; ++b)
#pragma unroll
                    for (int m = 0; m < 4; ++m)
#pragma unroll
                        for (int n = 0; n < 2; ++n) acc[a][b][m][n] = (f32x4){0.f, 0.f, 0.f, 0.f};
        }
        cur = nxt; cpart = npart; cA = nA; cB = nB; ++ui;
        if (wr == 1) PG8_BAR;
    }
    PG8_WAIT_V(0);
    PG8_BAR;
#undef PG8_SA
#undef PG8_SB
#undef PG8_STAGE
#undef PG8_LDA
#undef PG8_LDB
#undef PG8_MMA
#undef PG8_WAIT_V
#undef PG8_WAIT_L
#undef PG8_BAR
#undef PG8_SCHED
#undef PG8_GETU
}
}

namespace att {
constexpr int NW = 8, QBLK = 32, KVBLK = 64;
constexpr float SCALE = 0.125f;
constexpr float THR = 8.f;
constexpr int SHM_V = KVBLK * 128 * 2, SHM_K = KVBLK * 128 * 2;
constexpr int LDK = INW;
#define KSWZ(row, colB) ((row) * 256 + ((colB) ^ (((row) & 7) << 4)))
#define SBAR() __builtin_amdgcn_sched_barrier(0)
__device__ __forceinline__ int crow(int r, int hi) { return (r & 3) + 8 * (r >> 2) + 4 * hi; }
__device__ __forceinline__ unsigned cvtpk(float lo, float hi) { unsigned r; asm volatile("v_cvt_pk_bf16_f32 %0, %1, %2" : "=v"(r) : "v"(lo), "v"(hi)); return r; }

__device__ __forceinline__ void partialSM(f32x16& p0, f32x16& p1, float& m_reg, float& mn, float& alpha) {
    constexpr float C = SCALE * 1.4426950408889634f;
    float pmax = p0[0];
#pragma unroll
    for (int r = 1; r < 16; ++r) pmax = fmaxf(pmax, p0[r]);
#pragma unroll
    for (int r = 0; r < 16; ++r) pmax = fmaxf(pmax, p1[r]);
    { auto rr = __builtin_amdgcn_permlane32_swap(__float_as_uint(pmax), __float_as_uint(pmax), false, false);
      pmax = fmaxf(__uint_as_float(rr[0]), __uint_as_float(rr[1])); }
    if (__builtin_expect(__all(pmax - m_reg <= THR / SCALE), 1)) { mn = m_reg; alpha = 1.f; }
    else { mn = fmaxf(m_reg, pmax); alpha = __builtin_amdgcn_exp2f((m_reg - mn) * C); m_reg = mn; }
    float mnC = -mn * C;
#pragma unroll
    for (int r = 0; r < 16; ++r) p0[r] = fmaf(p0[r], C, mnC);
#pragma unroll
    for (int r = 0; r < 16; ++r) p1[r] = fmaf(p1[r], C, mnC);
#pragma unroll
    for (int r = 0; r < 16; ++r) p0[r] = __builtin_amdgcn_exp2f(p0[r]);
}
__device__ __forceinline__ void finishSM(f32x16& p0, f32x16& p1, float alpha, float& l_reg, bf16x8& pa0, bf16x8& pa1, bf16x8& pa2, bf16x8& pa3) {
#pragma unroll
    for (int r = 0; r < 16; ++r) p1[r] = __builtin_amdgcn_exp2f(p1[r]);
    float ps = 0;
#pragma unroll
    for (int r = 0; r < 16; ++r) ps += p0[r];
#pragma unroll
    for (int r = 0; r < 16; ++r) ps += p1[r];
    { auto rr = __builtin_amdgcn_permlane32_swap(__float_as_uint(ps), __float_as_uint(ps), false, false);
      ps = __uint_as_float(rr[0]) + __uint_as_float(rr[1]); }
    l_reg = l_reg * alpha + ps;
#define PK4(P, BASE, OUT) do { unsigned a0 = cvtpk(P[BASE + 0], P[BASE + 1]), a1 = cvtpk(P[BASE + 2], P[BASE + 3]);   \
    unsigned b0 = cvtpk(P[BASE + 4], P[BASE + 5]), b1 = cvtpk(P[BASE + 6], P[BASE + 7]);                              \
    auto r0 = __builtin_amdgcn_permlane32_swap(a0, b0, false, false); auto r1 = __builtin_amdgcn_permlane32_swap(a1, b1, false, false); \
    u32x4 w = {r0[0], r1[0], r0[1], r1[1]}; OUT = *reinterpret_cast<bf16x8*>(&w); } while (0)
    PK4(p0, 0, pa0); PK4(p0, 8, pa1); PK4(p1, 0, pa2); PK4(p1, 8, pa3);
#undef PK4
}
__device__ __forceinline__ void qkt(f32x16& p0, f32x16& p1, const char* Ks, const bf16x8* qr, int r32, int hi, int cofs) {
    p0 = f32x16{}; p1 = f32x16{};
#pragma unroll
    for (int d0 = 0; d0 < 4; ++d0) { int cb = (cofs + d0 * 16 + hi * 8) * 2;
        bf16x8 b0 = *reinterpret_cast<const bf16x8*>(Ks + KSWZ(r32, cb));
        bf16x8 b1 = *reinterpret_cast<const bf16x8*>(Ks + KSWZ(32 + r32, cb));
        p0 = __builtin_amdgcn_mfma_f32_32x32x16_bf16(b0, qr[d0], p0, 0, 0, 0);
        p1 = __builtin_amdgcn_mfma_f32_32x32x16_bf16(b1, qr[d0], p1, 0, 0, 0); }
}
__device__ __forceinline__ int v_st(int k, int c) { const int kk = (k & ~0xC) | ((k & 4) << 1) | ((k & 8) >> 1); return ((kk >> 3) * 4 + (c >> 5)) * 512 + ((kk & 7) * 32 + (c & 31)) * 2; }
__device__ __forceinline__ int v_rd_base(int lane) { return ((lane & 3) << 3) | (((lane >> 2) & 3) << 6) | (((lane >> 4) & 1) << 5) | (((lane >> 5) & 1) << 8); }
constexpr int v_rd_off(int d0, int ks, int half) { return d0 * 512 + ks * 4096 + half * 2048; }
template <int OFF> __device__ __forceinline__ s16x4 tr_read(int vb) {
    s16x4 r; asm volatile("ds_read_b64_tr_b16 %0, %1 offset:%2" : "=&v"(r) : "v"(vb), "i"(OFF) : "memory"); return r;
}
template <int D0> __device__ __forceinline__ void pv_one(f32x16& od, int vb, bf16x8 pa0, bf16x8 pa1, bf16x8 pa2, bf16x8 pa3) {
    const s16x4 l0 = tr_read<v_rd_off(D0, 0, 0)>(vb), h0 = tr_read<v_rd_off(D0, 0, 1)>(vb), l1 = tr_read<v_rd_off(D0, 1, 0)>(vb), h1 = tr_read<v_rd_off(D0, 1, 1)>(vb);
    const s16x4 l2 = tr_read<v_rd_off(D0, 2, 0)>(vb), h2 = tr_read<v_rd_off(D0, 2, 1)>(vb), l3 = tr_read<v_rd_off(D0, 3, 0)>(vb), h3 = tr_read<v_rd_off(D0, 3, 1)>(vb);
    asm volatile("s_waitcnt lgkmcnt(0)" ::: "memory"); SBAR();
#define PK(L, H) (bf16x8){L[0], L[1], L[2], L[3], H[0], H[1], H[2], H[3]}
    od = __builtin_amdgcn_mfma_f32_32x32x16_bf16(pa0, PK(l0, h0), od, 0, 0, 0);
    od = __builtin_amdgcn_mfma_f32_32x32x16_bf16(pa1, PK(l1, h1), od, 0, 0, 0);
    od = __builtin_amdgcn_mfma_f32_32x32x16_bf16(pa2, PK(l2, h2), od, 0, 0, 0);
    od = __builtin_amdgcn_mfma_f32_32x32x16_bf16(pa3, PK(l3, h3), od, 0, 0, 0);
#undef PK
}
__device__ __forceinline__ void pv_d0(f32x16* o, int vb, bf16x8 pa0, bf16x8 pa1, bf16x8 pa2, bf16x8 pa3) {
    pv_one<0>(o[0], vb, pa0, pa1, pa2, pa3); pv_one<1>(o[1], vb, pa0, pa1, pa2, pa3); pv_one<2>(o[2], vb, pa0, pa1, pa2, pa3); pv_one<3>(o[3], vb, pa0, pa1, pa2, pa3);
}

__device__ __forceinline__ void attn_unit(const bf16_t* __restrict__ Qb, const bf16_t* __restrict__ Kh, const bf16_t* __restrict__ Vh,
                                          bf16_t* __restrict__ Ob, int seq, char* lds, float lam, const float* __restrict__ subln_g) {
    int tid = threadIdx.x; asm volatile("" : "+v"(tid));
    const int wid = tid >> 6, lane = tid & 63, r32 = lane & 31, hi = lane >> 5;
    const int cmap = wid >> 2, wq = wid & 3, cofs = cmap * 64;
    char* V_lds = lds; char* K_lds = lds + 2 * SHM_V;
    float* ws = (float*)(lds + 2 * SHM_V + 2 * SHM_K) + wid * 64; float* li_l = ws; float* al_l = ws + 32;
    float m_reg = -1e30f, l_reg = 0; f32x16 o[4] = {}; bf16x8 qr[4];
    const bf16_t* Qw = Qb + (long)(wq * QBLK + r32) * LDK + cofs + hi * 8;
#pragma unroll
    for (int d0 = 0; d0 < 4; ++d0) qr[d0] = *reinterpret_cast<const bf16x8*>(Qw + d0 * 16);
    const int sr = tid >> 4, sc = (tid & 15) * 8, vst0 = v_st(sr, sc), vst1 = v_st(32 + sr, sc);
    const int vb0 = (int)(uintptr_t)V_lds + v_rd_base(lane);
    struct { bf16x8 vs0, vs1, ks0, ks1; } sr_[2];
#define SLOAD(i, k0) do { sr_[i].vs0 = *reinterpret_cast<const bf16x8*>(&Vh[(long)((k0) + sr) * LDK + sc]); sr_[i].vs1 = *reinterpret_cast<const bf16x8*>(&Vh[(long)((k0) + 32 + sr) * LDK + sc]); \
    sr_[i].ks0 = *reinterpret_cast<const bf16x8*>(&Kh[(long)((k0) + sr) * LDK + sc]); sr_[i].ks1 = *reinterpret_cast<const bf16x8*>(&Kh[(long)((k0) + 32 + sr) * LDK + sc]); } while (0)
#define SWRITE(b, i) do { *(bf16x8*)(V_lds + (b) * SHM_V + vst0) = sr_[i].vs0;          \
    *(bf16x8*)(V_lds + (b) * SHM_V + vst1) = sr_[i].vs1; int kc = sc * 2;               \
    *(bf16x8*)(K_lds + (b) * SHM_K + KSWZ(sr, kc)) = sr_[i].ks0;                       \
    *(bf16x8*)(K_lds + (b) * SHM_K + KSWZ(32 + sr, kc)) = sr_[i].ks1; } while (0)
#define SWAIT() asm volatile("s_waitcnt vmcnt(4)" ::: "memory")
#define RESC(a) do { if (__any((a) < 1.f)) { if (hi == 0) al_l[r32] = (a); asm volatile("s_waitcnt lgkmcnt(0)" ::: "memory"); \
    _Pragma("unroll") for (int d = 0; d < 4; ++d) _Pragma("unroll") for (int r = 0; r < 16; ++r) o[d][r] *= al_l[crow(r, hi)]; } } while (0)
    f32x16 pA0, pA1, pB0, pB1; float mnA, mnB, alA, alB; bf16x8 pa0, pa1, pa2, pa3; const int NT = seq / KVBLK;
    constexpr int SE = 0, SO = 1;
    SLOAD(SE, 0); asm volatile("s_waitcnt vmcnt(0)" ::: "memory"); SWRITE(0, SE); __syncthreads();
    qkt(pA0, pA1, K_lds, qr, r32, hi, cofs); partialSM(pA0, pA1, m_reg, mnA, alA);
    SLOAD(SO, KVBLK); if (2 < NT) SLOAD(SE, 2 * KVBLK);
    SWAIT(); SWRITE(1, SO); __syncthreads();
    for (int j = 1; j + 1 < NT; j += 2) {
        SBAR(); qkt(pB0, pB1, K_lds + SHM_K, qr, r32, hi, cofs);
        finishSM(pA0, pA1, alA, l_reg, pa0, pa1, pa2, pa3); SBAR();
        SLOAD(SO, (j + 2) * KVBLK); SBAR();
        pv_d0(o, vb0, pa0, pa1, pa2, pa3); partialSM(pB0, pB1, m_reg, mnB, alB);
        __syncthreads(); SWAIT(); SWRITE(0, SE);
        RESC(alB); __syncthreads();
        SBAR(); qkt(pA0, pA1, K_lds, qr, r32, hi, cofs);
        finishSM(pB0, pB1, alB, l_reg, pa0, pa1, pa2, pa3); SBAR();
        if (j + 3 < NT) SLOAD(SE, (j + 3) * KVBLK); SBAR();
        pv_d0(o, vb0 + (int)SHM_V, pa0, pa1, pa2, pa3); partialSM(pA0, pA1, m_reg, mnA, alA);
        __syncthreads(); SWAIT(); SWRITE(1, SO);
        RESC(alA); __syncthreads();
    }
    SBAR(); qkt(pB0, pB1, K_lds + SHM_K, qr, r32, hi, cofs);
    finishSM(pA0, pA1, alA, l_reg, pa0, pa1, pa2, pa3); SBAR();
    pv_d0(o, vb0, pa0, pa1, pa2, pa3); partialSM(pB0, pB1, m_reg, mnB, alB);
    __syncthreads(); RESC(alB);
    finishSM(pB0, pB1, alB, l_reg, pa0, pa1, pa2, pa3); SBAR();
    pv_d0(o, vb0 + (int)SHM_V, pa0, pa1, pa2, pa3);
    if (hi == 0) li_l[r32] = l_reg; asm volatile("s_waitcnt lgkmcnt(0)" ::: "memory");
    float rli[16];
#pragma unroll
    for (int r = 0; r < 16; ++r) rli[r] = __builtin_amdgcn_rcpf(li_l[crow(r, hi)]);
    __syncthreads();
    float* X = (float*)lds;
    if (cmap == 1) {
#pragma unroll
        for (int d0 = 0; d0 < 4; ++d0)
#pragma unroll
            for (int r = 0; r < 16; ++r) X[((wq * 4 + d0) * 16 + r) * 64 + lane] = o[d0][r] * rli[r];
    }
    __syncthreads();
    if (cmap == 0) {
        float ss[16];
#pragma unroll
        for (int r = 0; r < 16; ++r) { float s = 0.f;
#pragma unroll
            for (int d0 = 0; d0 < 4; ++d0) { const float v = o[d0][r] * rli[r] - lam * X[((wq * 4 + d0) * 16 + r) * 64 + lane]; o[d0][r] = v; s += v * v; }
            ss[r] = s; }
#pragma unroll
        for (int r = 0; r < 16; ++r) {
#pragma unroll
            for (int mk = 1; mk < 32; mk <<= 1) ss[r] += __shfl_xor(ss[r], mk);
            ss[r] = __builtin_amdgcn_rsqf(ss[r] * (1.0f / 128.0f) + 1e-5f);
        }
        float gsc[4];
#pragma unroll
        for (int d0 = 0; d0 < 4; ++d0) gsc[d0] = subln_g[d0 * 32 + r32] * 0.8f;
        bf16_t* Ow = Ob + (long)(wq * QBLK) * DM;
#pragma unroll
        for (int r = 0; r < 16; ++r) { const int orow = crow(r, hi);
#pragma unroll
            for (int d0 = 0; d0 < 4; ++d0) Ow[(long)orow * DM + d0 * 32 + r32] = (bf16_t)f2bf(o[d0][r] * ss[r] * gsc[d0]); }
    }
    __syncthreads();
#undef SLOAD
#undef SWRITE
#undef SWAIT
#undef RESC
}
#undef SBAR
}

template <bool APPLY>
__device__ __forceinline__ void lru_phase(LAS unsigned char* lds, int vcu, int G, int wave, int lane,
                                          const bf16_t* __restrict__ PROJ, bf16_t* __restrict__ REC, const bf16_t* __restrict__ WG,
                                          const float* __restrict__ conv_w, const float* __restrict__ conv_b, const float* __restrict__ b_gates,
                                          const float* __restrict__ lru_lam, f32x2* __restrict__ AGG, int S) {
    const int r32 = lane & 31, hi = lane >> 5;
    LAS unsigned char* T = lds + wave * 19456; LAS unsigned char* Y = T + 9792;
    constexpr int ntc = CH / 64, ntask = ntc * 16;
    const int ncs = S / 64;
    for (int task = vcu * 8 + wave; task < ntask; task += G * 8) {
        const int n = task & 15, tc = task >> 4, t0 = tc * 64, cs = tc % ncs, s0 = cs * 64;
#pragma unroll
        for (int i = 0; i < 9; ++i) { const int rr = (lane >> 3) + 8 * i;
            if (rr < 68) { const int sp = s0 - 2 + rr; u32x4 v = (u32x4){0u, 0u, 0u, 0u};
                if (sp >= 0 && sp < S) v = *(const u32x4*)(PROJ + (size_t)(t0 - 2 + rr) * INW + 3072 + n * 64 + (lane & 7) * 8);
                *(LAS u32x4*)(T + rr * 144 + (lane & 7) * 16) = v; } }
        if (APPLY) {
#pragma unroll
            for (int i = 0; i < 8; ++i) { const int rr = (lane >> 3) + 8 * i;
                const u32x4 v = *(const u32x4*)(PROJ + (size_t)(t0 + rr) * INW + 4096 + n * 64 + (lane & 7) * 8);
                *(LAS u32x4*)(Y + rr * 144 + (lane & 7) * 16) = v; }
        }
        {
            float xcv[2][2][16];
#pragma unroll
            for (int tj = 0; tj < 2; ++tj) { const int e = r32 + 32 * tj, ch = n * 64 + e;
                const float w0 = conv_w[ch], w1 = conv_w[1024 + ch], w2 = conv_w[2048 + ch], w3 = conv_w[3072 + ch], cb = conv_b[ch];
#pragma unroll
                for (int ti = 0; ti < 2; ++ti)
#pragma unroll
                    for (int q = 0; q < 4; ++q) { const int tb = 32 * ti + 8 * q + 4 * hi; float raw[7];
#pragma unroll
                        for (int j = 0; j < 7; ++j) raw[j] = bf2f(*(const LAS unsigned short*)(T + (tb + j) * 144 + e * 2));
#pragma unroll
                        for (int k = 0; k < 4; ++k) xcv[tj][ti][4 * q + k] = cb + w0 * raw[k] + w1 * raw[k + 1] + w2 * raw[k + 2] + w3 * raw[k + 3]; }
            }
            asm volatile("s_waitcnt lgkmcnt(0)" ::: "memory");
#pragma unroll
            for (int tj = 0; tj < 2; ++tj) { const int e = r32 + 32 * tj;
#pragma unroll
                for (int ti = 0; ti < 2; ++ti)
#pragma unroll
                    for (int r = 0; r < 16; ++r) { const int tl = 32 * ti + (r & 3) + 8 * (r >> 2) + 4 * hi;
                        *(LAS unsigned short*)(T + tl * 144 + e * 2) = (unsigned short)f2bf(xcv[tj][ti][r]); } }
        }
        asm volatile("s_waitcnt lgkmcnt(0)" ::: "memory");
#pragma unroll 1
        for (int tj = 0; tj < 2; ++tj) {
            const int e = r32 + 32 * tj, ch = n * 64 + e;
            float hs[2][16];
#pragma unroll
            for (int ti = 0; ti < 2; ++ti)
#pragma unroll
                for (int r = 0; r < 16; ++r) hs[ti][r] = 0.f;
#pragma unroll
            for (int dir = 0; dir < 2; ++dir) {
                f32x16 pr[2], pi[2];
                pr[0] = f32x16{}; pr[1] = f32x16{}; pi[0] = f32x16{}; pi[1] = f32x16{};
                const bf16_t* wrp = WG + (size_t)((dir * 2 + 0) * 16 + n) * 4096 + e * 64 + 8 * hi;
                const bf16_t* wip = WG + (size_t)((dir * 2 + 1) * 16 + n) * 4096 + e * 64 + 8 * hi;
                asm volatile("" ::: "memory");
#pragma unroll
                for (int ks = 0; ks < 4; ++ks) {
                    const bf16x8 br = *(const bf16x8*)(wrp + 16 * ks), bi = *(const bf16x8*)(wip + 16 * ks);
#pragma unroll
                    for (int ti = 0; ti < 2; ++ti) {
                        const bf16x8 af = *(const LAS bf16x8*)(T + (r32 + 32 * ti) * 144 + (16 * ks + 8 * hi) * 2);
                        pr[ti] = __builtin_amdgcn_mfma_f32_32x32x16_bf16(af, br, pr[ti], 0, 0, 0);
                        pi[ti] = __builtin_amdgcn_mfma_f32_32x32x16_bf16(af, bi, pi[ti], 0, 0, 0);
                    }
                }
                const float bias_r = b_gates[(dir * 2 + 0) * 1024 + ch], bias_i = b_gates[(dir * 2 + 1) * 1024 + ch];
                const float lamv = lru_lam[dir * 1024 + ch];
                const float z = fast_exp(-lamv);
                const float sp = (z < 0.05f) ? z * (1.0f + z * (-0.5f + z * (0.33333333f + z * (-0.25f + z * 0.2f)))) : __logf(1.0f + z);
                const float cdir = -8.0f * sp;
#pragma unroll
                for (int ti = 0; ti < 2; ++ti)
#pragma unroll
                    for (int r = 0; r < 16; ++r) {
                        const float rg = sigmoidf_(pr[ti][r] + bias_r), ig = sigmoidf_(pi[ti][r] + bias_i);
                        const float la = cdir * rg, a = fast_exp(la), y = 2.0f * la;
                        const float omp = -y * (1.0f + y * (0.5f + y * (0.16666667f + y * (0.041666668f + y * (0.0083333338f + y * 0.0013888889f)))));
                        const float om = (y > -0.3f) ? omp : (1.0f - a * a);
                        const float xv = bf2f(*(const LAS unsigned short*)(T + (32 * ti + (r & 3) + 8 * (r >> 2) + 4 * hi) * 144 + e * 2));
                        pr[ti][r] = a; pi[ti][r] = __builtin_amdgcn_sqrtf(om) * ig * xv;
                    }
#pragma unroll
                for (int ti = 0; ti < 2; ++ti)
#pragma unroll
                    for (int q = 0; q < 4; ++q) {
                        if (dir == 0) {
#pragma unroll
                            for (int k = 1; k < 4; ++k) { const int ix = 4 * q + k; pi[ti][ix] = fmaf(pr[ti][ix], pi[ti][ix - 1], pi[ti][ix]); pr[ti][ix] = pr[ti][ix] * pr[ti][ix - 1]; }
                        } else {
#pragma unroll
                            for (int k = 2; k >= 0; --k) { const int ix = 4 * q + k; pi[ti][ix] = fmaf(pr[ti][ix], pi[ti][ix + 1], pi[ti][ix]); pr[ti][ix] = pr[ti][ix] * pr[ti][ix + 1]; }
                        }
                    }
                float h = 0.f;
                if (APPLY) {
                    if (dir == 0) { const f32x2* ap = AGG + ((size_t)(0 * ntc + (tc - cs))) * 1024 + ch;
                        for (int c2 = 0; c2 < cs; ++c2) { const f32x2 ab = ap[(size_t)c2 * 1024]; h = fmaf(ab.x, h, ab.y); } }
                    else { const f32x2* ap = AGG + ((size_t)(1 * ntc + (tc - cs))) * 1024 + ch;
                        for (int c2 = ncs - 1; c2 > cs; --c2) { const f32x2 ab = ap[(size_t)c2 * 1024]; h = fmaf(ab.x, h, ab.y); } }
                }
                float hin[8]; float pa = 1.f;
#pragma unroll
                for (int gg = 0; gg < 16; ++gg) {
                    const int g = (dir == 0) ? gg : 15 - gg, j = g >> 1, ti = j >> 2, q = j & 3, cix = (dir == 0) ? 4 * q + 3 : 4 * q;
                    const bool own = ((g & 1) == hi);
                    const float Pc = pr[ti][cix], Lc = pi[ti][cix];
                    const float ho = fmaf(Pc, h, Lc);
                    const float ot = __shfl_xor(ho, 32);
                    if ((g & 1) == ((dir == 0) ? 0 : 1)) hin[j] = h;
                    hin[j] = own ? h : hin[j];
                    h = own ? ho : ot;
                    if ((g & 1) == 0) pa *= Pc;
                }
                if (APPLY) {
#pragma unroll
                    for (int j = 0; j < 8; ++j)
#pragma unroll
                        for (int k = 0; k < 4; ++k) { const int ti = j >> 2, ix = 4 * (j & 3) + k; hs[ti][ix] += fmaf(pr[ti][ix], hin[j], pi[ti][ix]); }
                } else {
                    pa *= __shfl_xor(pa, 32);
                    if (hi == 0) AGG[((size_t)(dir * ntc + tc)) * 1024 + ch] = (f32x2){pa, h};
                }
                __builtin_amdgcn_sched_barrier(0);
            }
            if (APPLY) {
#pragma unroll
                for (int ti = 0; ti < 2; ++ti)
#pragma unroll
                    for (int r = 0; r < 16; ++r) { const int tl = 32 * ti + (r & 3) + 8 * (r >> 2) + 4 * hi;
                        LAS unsigned short* yp = (LAS unsigned short*)(Y + tl * 144 + e * 2);
                        const float yv = bf2f(*yp);
                        const float u = 0.7978845608f * (yv + 0.044715f * yv * yv * yv);
                        const float ge = yv * __builtin_amdgcn_rcpf(1.0f + fast_exp(-2.0f * u));
                        *yp = (unsigned short)f2bf(hs[ti][r] * ge); }
            }
        }
        if (APPLY) {
            asm volatile("s_waitcnt lgkmcnt(0)" ::: "memory");
#pragma unroll
            for (int i = 0; i < 8; ++i) { const int rr = (lane >> 3) + 8 * i;
                const u32x4 v = *(const LAS u32x4*)(Y + rr * 144 + (lane & 7) * 16);
                *(u32x4*)(REC + (size_t)(t0 + rr) * DM + n * 64 + (lane & 7) * 8) = v; }
        }
        asm volatile("s_waitcnt lgkmcnt(0)" ::: "memory");
    }
}

template <int MODE> __device__ __forceinline__ int sigma_col(int g) {
    if (MODE == 1) { if (g >= 2048) return g; const int p = g & 63; return (g & ~63) + 4 * (p >> 3) + (p & 3) + 32 * ((p >> 2) & 1); }
    if (MODE == 2) { const int i = g >> 3, half = (g >> 2) & 1, e = g & 3; return half * DFF + 4 * i + e; }
    return g;
}
template <int MODE>
__device__ __forceinline__ void transpose_item(const float* __restrict__ W, int K, int N, bf16_t* __restrict__ WT, LAS float* scr, int item, int lane) {
    const int nblk = N / 32, kb = item / nblk, nb = item % nblk, k0 = 64 * kb, n0 = 32 * nb;
    const int scol = sigma_col<MODE>(n0 + (lane & 31));
#pragma unroll 8
    for (int i = 0; i < 32; ++i) { const int kk = 2 * i + (lane >> 5); scr[kk * 33 + (lane & 31)] = W[(size_t)(k0 + kk) * N + scol]; }
    asm volatile("s_waitcnt lgkmcnt(0)" ::: "memory");
    const int c = lane & 7;
#pragma unroll
    for (int j = 0; j < 4; ++j) { const int nn = (lane >> 3) + 8 * j; const LAS float* s = scr + (8 * c) * 33 + nn;
        u32x4 o; o.x = f2bf(s[0 * 33]) | (f2bf(s[1 * 33]) << 16); o.y = f2bf(s[2 * 33]) | (f2bf(s[3 * 33]) << 16); o.z = f2bf(s[4 * 33]) | (f2bf(s[5 * 33]) << 16); o.w = f2bf(s[6 * 33]) | (f2bf(s[7 * 33]) << 16);
        *(u32x4*)(WT + (size_t)(n0 + nn) * K + k0 + 8 * c) = o; }
    asm volatile("s_waitcnt lgkmcnt(0)" ::: "memory");
}

struct KArgs { const float* in[26]; float* out; unsigned char* ws; int ph_lo, ph_hi; };
constexpr int NPHASE = 2 + NCHUNK * 10;

__global__ void __launch_bounds__(512, 2) mk_fwd(KArgs a) {
    extern __shared__ __attribute__((aligned(16))) unsigned char lds[];
    cg::grid_group grid = cg::this_grid();
    const int G = gridDim.x, bx = blockIdx.x;
    const int vcu = (G % 8 == 0) ? (bx % 8) * (G / 8) + bx / 8 : bx;
    const int NGW = G * 8;
    LAS unsigned char* ldsl = (LAS unsigned char*)lds;

    for (int ph = a.ph_lo; ph < a.ph_hi; ++ph) {
        size_t zoff = 0; asm volatile("" : "+s"(zoff));
        unsigned char* ws = a.ws + zoff;
        int tid = threadIdx.x; asm volatile("" : "+v"(tid));
        const int lane = tid & 63, wave = __builtin_amdgcn_readfirstlane(tid >> 6), gw = vcu * 8 + wave;
        bf16_t* Win_t = (bf16_t*)(ws + WS_WIN); bf16_t* Wab_t = (bf16_t*)(ws + WS_WAB); bf16_t* Wlb_t = (bf16_t*)(ws + WS_WLB); bf16_t* Wout_t = (bf16_t*)(ws + WS_WOUT);
        bf16_t* Wfi_t = (bf16_t*)(ws + WS_WFI); bf16_t* Wfo_t = (bf16_t*)(ws + WS_WFO); bf16_t* WG = (bf16_t*)(ws + WS_WG);
        float* MODP = (float*)(ws + WS_MODP); float* MOD = (float*)(ws + WS_MOD); float* ROPE = (float*)(ws + WS_ROPE); float* MISC = (float*)(ws + WS_MISC);
        f32x2* AGG = (f32x2*)(ws + WS_AGG);
        bf16_t* Hb = (bf16_t*)(ws + WS_H); bf16_t* ATTN = (bf16_t*)(ws + WS_ATTN); bf16_t* REC = (bf16_t*)(ws + WS_REC); bf16_t* MRG = (bf16_t*)(ws + WS_MRG);
        float* X1 = (float*)(ws + WS_X1); bf16_t* PROJ = (bf16_t*)(ws + WS_PROJ); bf16_t* ACT = (bf16_t*)(ws + WS_PROJ);
        const int kk = (ph >= 2) ? (ph - 2) % 10 : -1, chunk = (ph >= 2) ? (ph - 2) / 10 : 0;
        if (ph > a.ph_lo && !(kk == 0 && chunk > 0)) grid.sync();
        const int row0 = chunk * CH, S = (chunk == 0) ? 4096 : 2048, b0 = batch_of_row(row0);
        const float* xin = (chunk == 0) ? a.in[0] : a.in[1] + (size_t)(row0 - M_P) * DM;
        float* outc = a.out + (size_t)row0 * DM;

        if (ph == 0 && PHON(10)) {
            LAS float* scr = (LAS float*)(ldsl + wave * 16384);
            constexpr int I_IN = (DM / 64) * (INW / 32), I_SQ = (DM / 64) * (DM / 32), I_FI = (DM / 64) * (2 * DFF / 32), I_FO = (DFF / 64) * (DM / 32), I_G = 64 * 2;
            constexpr int NITEMS = I_IN + 3 * I_SQ + I_FI + I_FO + I_G;
            for (int it = gw; it < NITEMS; it += NGW) {
                int r = it;
                if (r < I_IN) { transpose_item<1>(a.in[6], DM, INW, Win_t, scr, r, lane); continue; } r -= I_IN;
                if (r < I_SQ) { transpose_item<0>(a.in[17], DM, DM, Wab_t, scr, r, lane); continue; } r -= I_SQ;
                if (r < I_SQ) { transpose_item<0>(a.in[18], DM, DM, Wlb_t, scr, r, lane); continue; } r -= I_SQ;
                if (r < I_SQ) { transpose_item<0>(a.in[19], DM, DM, Wout_t, scr, r, lane); continue; } r -= I_SQ;
                if (r < I_FI) { transpose_item<2>(a.in[22], DM, 2 * DFF, Wfi_t, scr, r, lane); continue; } r -= I_FI;
                if (r < I_FO) { transpose_item<0>(a.in[23], DFF, DM, Wfo_t, scr, r, lane); continue; } r -= I_FO;
                { const int mat = r >> 1; transpose_item<0>(a.in[14] + (size_t)mat * 4096, 64, 64, WG + (size_t)mat * 4096, scr, r & 1, lane); }
            }
            for (int idx = gw * 64 + lane; idx < 4096 * 32; idx += NGW * 64) {
                const int pos = idx >> 5, i = idx & 31;
                const float inv = __builtin_amdgcn_exp2f(-(float)i * (13.287712379549449f / 32.0f));
                const float ang = (float)pos * inv;
                const double rev = (double)ang * 0.15915494309189535;
                const float fr = (float)(rev - floor(rev));
                ((f32x2*)ROPE)[idx] = (f32x2){__builtin_amdgcn_cosf(fr), __builtin_amdgcn_sinf(fr)};
            }
            if (gw == 0) {
                const float s1 = wave_sum(a.in[7][lane] * a.in[8][lane]), s2 = wave_sum(a.in[9][lane] * a.in[10][lane]);
                if (lane == 0) MISC[0] = fast_exp(s1) - fast_exp(s2) + 0.2f;
            }
            for (int t = gw; t < 96 * 5 * 4; t += NGW) {
                const int kq = t & 3, rg = (t >> 2) % 5, cgp = t / 20, col = cgp * 64 + lane;
                float accm[8];
#pragma unroll
                for (int r = 0; r < 8; ++r) accm[r] = 0.f;
                for (int kb = 0; kb < 4; ++kb) {
                    const int kbase = kq * 256 + kb * 64;
                    float sil[8];
#pragma unroll
                    for (int r = 0; r < 8; ++r) { const int row = rg * 8 + r; const float cv = (row < 8) ? a.in[2][row * DM + kbase + lane] : a.in[3][(row - 8) * DM + kbase + lane]; sil[r] = cv * sigmoidf_(cv); }
#pragma unroll 8
                    for (int j = 0; j < 64; ++j) {
                        const float w = a.in[4][(size_t)(kbase + j) * 6144 + col];
#pragma unroll
                        for (int r = 0; r < 8; ++r) accm[r] = fmaf(__int_as_float(__builtin_amdgcn_readlane(__float_as_int(sil[r]), j)), w, accm[r]);
                    }
                }
#pragma unroll
                for (int r = 0; r < 8; ++r) MODP[((size_t)kq * NMODROWS + rg * 8 + r) * 6144 + col] = accm[r];
            }
        } else if (ph == 1 && PHON(11)) {
            for (int idx = gw * 64 + lane; idx < NMODROWS * 6144; idx += NGW * 64) {
                const int col = idx % 6144;
                MOD[idx] = a.in[5][col] + ((MODP[idx] + MODP[(size_t)NMODROWS * 6144 + idx]) + (MODP[(size_t)2 * NMODROWS * 6144 + idx] + MODP[(size_t)3 * NMODROWS * 6144 + idx]));
            }
        } else if (kk == 0 && PHON(0)) {
            for (int row = gw; row < CH; row += NGW) {
                const int b = batch_of_row(row0 + row);
                const f32x4* xr = (const f32x4*)(xin + (size_t)row * DM) + lane;
                f32x4 v[4]; float s = 0.f;
#pragma unroll
                for (int j = 0; j < 4; ++j) { v[j] = xr[64 * j]; s += (v[j].x + v[j].y) + (v[j].z + v[j].w); }
                const float mean = wave_sum(s) * (1.f / DM); float s2 = 0.f;
#pragma unroll
                for (int j = 0; j < 4; ++j) { v[j] = v[j] - mean; s2 += (v[j].x * v[j].x + v[j].y * v[j].y) + (v[j].z * v[j].z + v[j].w * v[j].w); }
                const float rstd = __builtin_amdgcn_rsqf(wave_sum(s2) * (1.f / DM) + LN_EPS);
                const f32x4* shp = (const f32x4*)(MOD + (size_t)b * 6144) + lane; const f32x4* scp = (const f32x4*)(MOD + (size_t)b * 6144 + 1024) + lane;
                u32x2* o8 = (u32x2*)(Hb + (size_t)row * DM) + lane;
#pragma unroll
                for (int j = 0; j < 4; ++j) { const f32x4 sc = scp[64 * j], sh = shp[64 * j]; const f32x4 y = v[j] * rstd * (sc + 1.0f) + sh;
                    u32x2 w; w.x = cvt_pk_bf16(y.x, y.y); w.y = cvt_pk_bf16(y.z, y.w); o8[64 * j] = w; }
            }
        } else if (kk == 1 && PHON(1)) {
            pg8::Gemm g{Hb, Win_t, nullptr, nullptr, CH, INW, DM}; pg8::StaticOrder so; so.init(CH, INW, G, bx);
            pg8::EpiProj E{PROJ, (const f32x4*)ROPE, S};
            pg8::gemm_phase<pg8::EpiProj, false>(ldsl, g, so, E);
        } else if (kk == 2 && PHON(2)) {
            const float lam = MISC[0];
            const int nqb = S / 128, nunits = (CH / S) * 8 * nqb;
            for (int i = 0;; ++i) {
                const int unit = i * G + vcu; if (unit >= nunits) break;
                const int bh = unit / nqb, qb = unit % nqb, b = bh >> 3, h = bh & 7;
                const size_t rowbase = (size_t)b * S;
                att::attn_unit(PROJ + (rowbase + (size_t)qb * 128) * INW + h * 128, PROJ + rowbase * INW + 1024 + h * 128, PROJ + rowbase * INW + 2048 + h * 128,
                               ATTN + (rowbase + (size_t)qb * 128) * DM + h * 128, S, (char*)lds, lam, a.in[11]);
            }
            __syncthreads();
            if (PHON(12)) lru_phase<false>(ldsl, vcu, G, wave, lane, PROJ, REC, WG, a.in[12], a.in[13], a.in[15], a.in[16], AGG, S);
        } else if (kk == 3 && PHON(3)) {
            lru_phase<true>(ldsl, vcu, G, wave, lane, PROJ, REC, WG, a.in[12], a.in[13], a.in[15], a.in[16], AGG, S);
        } else if (kk == 4 && PHON(4)) {
            pg8::Gemm g{ATTN, Wab_t, REC, Wlb_t, CH, DM, DM}; pg8::StaticOrder so; so.init(CH, DM, G, bx);
            pg8::EpiMerge E{MRG, PROJ};
            pg8::gemm_phase<pg8::EpiMerge, true>(ldsl, g, so, E);
        } else if (kk == 5 && PHON(5)) {
            pg8::Gemm g{MRG, Wout_t, nullptr, nullptr, CH, DM, DM}; pg8::StaticOrder so; so.init(CH, DM, G, bx);
            pg8::EpiRes E{xin, outc, MOD + 2048, S, b0};
            pg8::gemm_phase<pg8::EpiRes, false>(ldsl, g, so, E);
        } else if (kk == 6 && PHON(6)) {
            for (int row = gw; row < CH; row += NGW) {
                const int b = batch_of_row(row0 + row);
                const f32x4* yr = (const f32x4*)(outc + (size_t)row * DM) + lane;
                f32x4 v[4]; float s = 0.f;
#pragma unroll
                for (int j = 0; j < 4; ++j) { v[j] = yr[64 * j]; s += (v[j].x + v[j].y) + (v[j].z + v[j].w); }
                float mean = wave_sum(s) * (1.f / DM); float s2 = 0.f;
#pragma unroll
                for (int j = 0; j < 4; ++j) { v[j] = v[j] - mean; s2 += (v[j].x * v[j].x + v[j].y * v[j].y) + (v[j].z * v[j].z + v[j].w * v[j].w); }
                float rstd = __builtin_amdgcn_rsqf(wave_sum(s2) * (1.f / DM) + LN_EPS);
                f32x4* x1p = (f32x4*)(X1 + (size_t)row * DM) + lane;
                s = 0.f;
#pragma unroll
                for (int j = 0; j < 4; ++j) { const f32x4 gg = ((const f32x4*)a.in[20])[lane + 64 * j], bb = ((const f32x4*)a.in[21])[lane + 64 * j];
                    v[j] = v[j] * rstd * gg + bb; x1p[64 * j] = v[j]; s += (v[j].x + v[j].y) + (v[j].z + v[j].w); }
                mean = wave_sum(s) * (1.f / DM); s2 = 0.f;
#pragma unroll
                for (int j = 0; j < 4; ++j) { v[j] = v[j] - mean; s2 += (v[j].x * v[j].x + v[j].y * v[j].y) + (v[j].z * v[j].z + v[j].w * v[j].w); }
                rstd = __builtin_amdgcn_rsqf(wave_sum(s2) * (1.f / DM) + LN_EPS);
                const f32x4* shp = (const f32x4*)(MOD + (size_t)b * 6144 + 3072) + lane; const f32x4* scp = (const f32x4*)(MOD + (size_t)b * 6144 + 4096) + lane;
                u32x2* o8 = (u32x2*)(Hb + (size_t)row * DM) + lane;
#pragma unroll
                for (int j = 0; j < 4; ++j) { const f32x4 sc = scp[64 * j], sh = shp[64 * j]; const f32x4 y = v[j] * rstd * (sc + 1.0f) + sh;
                    u32x2 w; w.x = cvt_pk_bf16(y.x, y.y); w.y = cvt_pk_bf16(y.z, y.w); o8[64 * j] = w; }
            }
        } else if (kk == 7 && PHON(7)) {
            pg8::Gemm g{Hb, Wfi_t, nullptr, nullptr, CH, 2 * DFF, DM}; pg8::StaticOrder so; so.init(CH, 2 * DFF, G, bx);
            pg8::EpiSwiGLU E{ACT};
            pg8::gemm_phase<pg8::EpiSwiGLU, false>(ldsl, g, so, E);
        } else if (kk == 8 && PHON(8)) {
            pg8::Gemm g{ACT, Wfo_t, nullptr, nullptr, CH, DM, DFF}; pg8::StaticOrder so; so.init(CH, DM, G, bx);
            pg8::EpiRes E{X1, outc, MOD + 5120, S, b0};
            pg8::gemm_phase<pg8::EpiRes, false>(ldsl, g, so, E);
        } else if (kk == 9 && PHON(9)) {
            for (int row = gw; row < CH; row += NGW) {
                f32x4* yr = (f32x4*)(outc + (size_t)row * DM) + lane;
                f32x4 v[4]; float s = 0.f;
#pragma unroll
                for (int j = 0; j < 4; ++j) { v[j] = yr[64 * j]; s += (v[j].x + v[j].y) + (v[j].z + v[j].w); }
                const float mean = wave_sum(s) * (1.f / DM); float s2 = 0.f;
#pragma unroll
                for (int j = 0; j < 4; ++j) { v[j] = v[j] - mean; s2 += (v[j].x * v[j].x + v[j].y * v[j].y) + (v[j].z * v[j].z + v[j].w * v[j].w); }
                const float rstd = __builtin_amdgcn_rsqf(wave_sum(s2) * (1.f / DM) + LN_EPS);
#pragma unroll
                for (int j = 0; j < 4; ++j) { const f32x4 gg = ((const f32x4*)a.in[24])[lane + 64 * j], bb = ((const f32x4*)a.in[25])[lane + 64 * j];
                    yr[64 * j] = v[j] * rstd * gg + bb; }
            }
        }
    }
}

extern "C" void kernel_launch(void* const* d_in, const int* in_sizes, int n_in, void* d_out, int out_size, void* d_ws, size_t ws_size, hipStream_t stream) {
    static int grid = 0;
    if (grid == 0) {
        if (n_in != 26 || out_size != M_ALL * DM || ws_size < WS_END) { fprintf(stderr, "kernel_launch: unexpected shapes n_in %d out %d ws %zu (need %zu)\n", n_in, out_size, ws_size, (size_t)WS_END); grid = -1; return; }
        int dev = 0, cus = 0, per_cu = 0;
        hipGetDevice(&dev); hipDeviceGetAttribute(&cus, hipDeviceAttributeMultiprocessorCount, dev);
        if (hipFuncSetAttribute((const void*)mk_fwd, hipFuncAttributeMaxDynamicSharedMemorySize, LDS_BYTES) != hipSuccess) { fprintf(stderr, "kernel_launch: hipFuncSetAttribute failed\n"); grid = -1; return; }
        hipOccupancyMaxActiveBlocksPerMultiprocessor(&per_cu, (const void*)mk_fwd, 512, LDS_BYTES);
        (void)hipGetLastError();
        if (per_cu < 1) fprintf(stderr, "kernel_launch: occupancy query says %d blocks/CU\n", per_cu);
        grid = cus;
    }
    if (grid < 0) return;
    KArgs a{};
    for (int i = 0; i < 26; ++i) a.in[i] = (const float*)d_in[i];
    a.out = (float*)d_out; a.ws = (unsigned char*)d_ws;
#if MK_MULTI
    for (int ph = 0; ph < NPHASE; ++ph) { a.ph_lo = ph; a.ph_hi = ph + 1; hipLaunchKernelGGL(mk_fwd, dim3(grid), dim3(512), LDS_BYTES, stream, a); }
#else
    a.ph_lo = 0; a.ph_hi = NPHASE;
    void* args[] = {&a};
    hipError_t e = hipLaunchCooperativeKernel((void*)mk_fwd, dim3(grid), dim3(512), args, LDS_BYTES, stream);
    if (e != hipSuccess) fprintf(stderr, "cooperative launch failed: %s (grid %d)\n", hipGetErrorString(e), grid);
#endif
}
```

```cpp
#include <hip/hip_runtime.h>
#include <hip/hip_cooperative_groups.h>
#include <cstdio>
#include <cstdint>
namespace cg = cooperative_groups;

#ifndef PH_MASK
#define PH_MASK 0xFFFF
#endif
#define PHON(k) ((PH_MASK >> (k)) & 1)
#ifndef REP_MASK
#define REP_MASK 0
#endif
#ifndef MK_MULTI
#define MK_MULTI 0
#endif

#define LAS __attribute__((address_space(3)))
typedef unsigned short bf16_t;
typedef short bf16x8 __attribute__((ext_vector_type(8)));
typedef short s16x4 __attribute__((ext_vector_type(4)));
typedef float f32x2 __attribute__((ext_vector_type(2)));
typedef float f32x4 __attribute__((ext_vector_type(4)));
typedef float f32x16 __attribute__((ext_vector_type(16)));
typedef unsigned u32x2 __attribute__((ext_vector_type(2)));
typedef unsigned u32x4 __attribute__((ext_vector_type(4)));

constexpr int DM = 1024, INW = 7168, DFF = 2816;
constexpr int M_P = 8 * 4096, M_S = 32 * 2048, M_ALL = M_P + M_S;
constexpr int CH = 32768, NCHUNK = 3;
constexpr int NMODROWS = 40;
constexpr float ALPHA = 1.189207115002721f;
constexpr float LN_EPS = 1e-5f;
constexpr float LOG2E = 1.4426950408889634f;

constexpr size_t MiB = 1u << 20;
constexpr size_t WS_WIN = 0, WS_WAB = 14 * MiB, WS_WLB = 16 * MiB, WS_WOUT = 18 * MiB, WS_WFI = 20 * MiB, WS_WFO = 31 * MiB, WS_WG = 37 * MiB;
constexpr size_t WS_MODP = 38 * MiB, WS_ROPE = 42 * MiB, WS_MISC = 43 * MiB, WS_AGG = 44 * MiB, WS_MOD = 52 * MiB;
constexpr size_t WS_CARRY = 56 * MiB, WS_BAR = 60 * MiB;
constexpr size_t WS_H = 64 * MiB, WS_ATTN = 128 * MiB, WS_REC = 192 * MiB, WS_MRG = 256 * MiB, WS_X1 = 320 * MiB, WS_PROJ = 448 * MiB, WS_END = 896 * MiB;

constexpr int LDS_BYTES = 155648 + 64, LDS_ST_OFF = 155648;

__device__ __forceinline__ unsigned cvt_pk_bf16(float lo, float hi) { unsigned r; asm volatile("v_cvt_pk_bf16_f32 %0, %1, %2" : "=v"(r) : "v"(lo), "v"(hi)); return r; }
__device__ __forceinline__ unsigned f2bf(float f) { unsigned u = __builtin_bit_cast(unsigned, f); return (u + 0x7fffu + ((u >> 16) & 1u)) >> 16; }
__device__ __forceinline__ float bf2f(unsigned short h) { return __uint_as_float((unsigned)h << 16); }
__device__ __forceinline__ float bflo(unsigned w) { return __uint_as_float(w << 16); }
__device__ __forceinline__ float bfhi(unsigned w) { return __uint_as_float(w & 0xffff0000u); }
__device__ __forceinline__ float fast_exp(float x) { return __builtin_amdgcn_exp2f(x * LOG2E); }
__device__ __forceinline__ float sigmoidf_(float x) { return __builtin_amdgcn_rcpf(1.0f + fast_exp(-x)); }
__device__ __forceinline__ float wave_sum(float v) {
#pragma unroll
    for (int o = 1; o < 64; o <<= 1) v += __shfl_xor(v, o);
    return v;
}
__device__ __forceinline__ int batch_of_row(int grow) { return grow < M_P ? (grow >> 12) : 8 + ((grow - M_P) >> 11); }

namespace pg8 {
constexpr int BM = 256, BK = 64, HALF = 128, HTB = HALF * BK * 2, STAGE_BYTES = 8 * HTB, NXCD = 8, WGM = 8;
__host__ __device__ __forceinline__ int lds_byte(int r, int c) { const int st = (r >> 4) * 2 + (c >> 5), rr = r & 15, cc = c & 31, ob = rr * 64 + cc * 2; return st * 1024 + (ob ^ (((ob >> 9) & 1) << 5)); }
__host__ __device__ __forceinline__ void stage_rc(int b, int& R, int& C) { const int st = b / 1024, sb = b % 1024, swz = sb ^ (((sb >> 9) & 1) << 5); R = (st >> 1) * 16 + swz / 64; C = (st & 1) * 32 + (swz % 64) / 2; }
__host__ __device__ __forceinline__ int perm32(int rho) { const int n = rho >> 4, i = rho & 15; return 8 * (i >> 2) + 4 * n + (i & 3); }

struct Unit { int pm, pn; };
struct Gemm { const bf16_t* A; const bf16_t* Bt; const bf16_t* A2; const bf16_t* Bt2; int M, N, K; };

struct StaticOrder {
    int nM, nN, nwg, G, c;
    __device__ void init(int M, int N, int G_, int c_) { nM = M / BM; nN = N / BM; nwg = nM * nN; G = G_; c = c_; }
    __device__ bool next(int i, Unit& u) const {
        const long L = (long)i * G + c; if (L >= nwg) return false;
        int wgid = (int)L; { const int q = nwg / NXCD, r = nwg % NXCD, xcd = wgid % NXCD, off = wgid / NXCD; wgid = (xcd < r ? xcd * (q + 1) : r * (q + 1) + (xcd - r) * q) + off; }
        const int nig = WGM * nN, gid = wgid / nig, fm = gid * WGM, gsz = (nM - fm) < WGM ? (nM - fm) : WGM;
        u.pm = fm + ((wgid % nig) % gsz); u.pn = (wgid % nig) / gsz; return true;
    }
};

typedef f32x4 AccT[2][2][4][2];

struct EpiProj {
    bf16_t* O; const f32x4* rope; int S;
    __device__ __forceinline__ void mid(AccT& acc, const Unit& u, int wr, int wc, int fr, int fq) const {}
    __device__ __forceinline__ void operator()(AccT& acc, const Unit& u, int wr, int wc, int fr, int fq) const {
        const int row0 = u.pm * BM + wr * 64 + fr, colt = u.pn * BM;
        if (u.pn < 8) {
            const int d0 = 16 * (wc & 1) + 4 * fq;
#pragma unroll
            for (int ai = 0; ai < 2; ++ai)
#pragma unroll
                for (int m = 0; m < 4; ++m) {
                    const int row = row0 + ai * HALF + m * 16, pos = row & (S - 1);
                    const f32x4 cs0 = rope[(pos * 32 + d0) >> 1], cs1 = rope[((pos * 32 + d0) >> 1) + 1];
                    const float c[4] = {cs0[0], cs0[2], cs1[0], cs1[2]}, s[4] = {cs0[1], cs0[3], cs1[1], cs1[3]};
#pragma unroll
                    for (int bj = 0; bj < 2; ++bj) {
                        const f32x4 t1 = acc[ai][bj][m][0], t2 = acc[ai][bj][m][1];
                        float o1[4], o2[4];
#pragma unroll
                        for (int e = 0; e < 4; ++e) { o1[e] = t1[e] * c[e] - t2[e] * s[e]; o2[e] = t2[e] * c[e] + t1[e] * s[e]; }
                        bf16_t* p = O + (size_t)row * INW + colt + bj * HALF + (wc >> 1) * 64 + d0;
                        u32x2 w1, w2; w1.x = cvt_pk_bf16(o1[0], o1[1]); w1.y = cvt_pk_bf16(o1[2], o1[3]); w2.x = cvt_pk_bf16(o2[0], o2[1]); w2.y = cvt_pk_bf16(o2[2], o2[3]);
                        *(u32x2*)p = w1; *(u32x2*)(p + 32) = w2;
                    }
                }
        } else {
            const int col0 = colt + wc * 32 + 8 * fq;
#pragma unroll
            for (int ai = 0; ai < 2; ++ai)
#pragma unroll
                for (int m = 0; m < 4; ++m) {
                    bf16_t* rowp = O + (size_t)(row0 + ai * HALF + m * 16) * INW + col0;
#pragma unroll
                    for (int bj = 0; bj < 2; ++bj) { const f32x4 v0 = acc[ai][bj][m][0], v1 = acc[ai][bj][m][1];
                        u32x4 w; w.x = cvt_pk_bf16(v0[0], v0[1]); w.y = cvt_pk_bf16(v0[2], v0[3]); w.z = cvt_pk_bf16(v1[0], v1[1]); w.w = cvt_pk_bf16(v1[2], v1[3]);
                        *(u32x4*)(rowp + bj * HALF) = w; }
                }
        }
    }
};

struct EpiMerge {
    bf16_t* O; const bf16_t* P;
    __device__ __forceinline__ void mid(AccT& acc, const Unit& u, int wr, int wc, int fr, int fq) const {
        const int row0 = u.pm * BM + wr * 64 + fr, col0 = u.pn * BM + wc * 32 + 8 * fq;
#pragma unroll
        for (int ai = 0; ai < 2; ++ai)
#pragma unroll
            for (int m = 0; m < 4; ++m) {
                const bf16_t* rp = P + (size_t)(row0 + ai * HALF + m * 16) * INW + col0;
#pragma unroll
                for (int bj = 0; bj < 2; ++bj) {
                    const u32x4 ga = *(const u32x4*)(rp + 5120 + bj * HALF), gl = *(const u32x4*)(rp + 6144 + bj * HALF);
#pragma unroll
                    for (int q = 0; q < 4; ++q) {
                        const float a0 = bflo(ga[q]), a1 = bfhi(ga[q]), l0 = bflo(gl[q]), l1 = bfhi(gl[q]);
                        const float r0 = (1.0f + fast_exp(-l0)) * __builtin_amdgcn_rcpf(1.0f + fast_exp(-a0));
                        const float r1 = (1.0f + fast_exp(-l1)) * __builtin_amdgcn_rcpf(1.0f + fast_exp(-a1));
                        acc[ai][bj][m][q >> 1][(q & 1) * 2 + 0] *= r0; acc[ai][bj][m][q >> 1][(q & 1) * 2 + 1] *= r1;
                    }
                }
            }
    }
    __device__ __forceinline__ void operator()(AccT& acc, const Unit& u, int wr, int wc, int fr, int fq) const {
        const int row0 = u.pm * BM + wr * 64 + fr, col0 = u.pn * BM + wc * 32 + 8 * fq;
#pragma unroll
        for (int ai = 0; ai < 2; ++ai)
#pragma unroll
            for (int m = 0; m < 4; ++m) {
                const size_t row = (size_t)(row0 + ai * HALF + m * 16);
                const bf16_t* rp = P + row * INW + col0;
#pragma unroll
                for (int bj = 0; bj < 2; ++bj) {
                    const u32x4 gl = *(const u32x4*)(rp + 6144 + bj * HALF);
                    float v[8];
#pragma unroll
                    for (int q = 0; q < 4; ++q) {
                        v[2 * q] = acc[ai][bj][m][q >> 1][(q & 1) * 2 + 0] * sigmoidf_(bflo(gl[q]));
                        v[2 * q + 1] = acc[ai][bj][m][q >> 1][(q & 1) * 2 + 1] * sigmoidf_(bfhi(gl[q]));
                    }
                    u32x4 w; w.x = cvt_pk_bf16(v[0], v[1]); w.y = cvt_pk_bf16(v[2], v[3]); w.z = cvt_pk_bf16(v[4], v[5]); w.w = cvt_pk_bf16(v[6], v[7]);
                    *(u32x4*)(O + row * DM + col0 + bj * HALF) = w;
                }
            }
    }
};

struct EpiRes {
    const float* base; float* Y; const float* gate  ; int S, b0;
    __device__ __forceinline__ void mid(AccT& acc, const Unit& u, int wr, int wc, int fr, int fq) const {}
    __device__ __forceinline__ void operator()(AccT& acc, const Unit& u, int wr, int wc, int fr, int fq) const {
        const int row0 = u.pm * BM + wr * 64 + fr, col0 = u.pn * BM + wc * 32 + 8 * fq;
        const float* gp = gate + (size_t)(b0 + (u.pm * BM) / S) * 6144 + col0;
        f32x4 gv[2][2];
#pragma unroll
        for (int bj = 0; bj < 2; ++bj)
#pragma unroll
            for (int n = 0; n < 2; ++n) gv[bj][n] = *(const f32x4*)(gp + bj * HALF + 4 * n);
#pragma unroll
        for (int ai = 0; ai < 2; ++ai)
#pragma unroll
            for (int m = 0; m < 4; ++m) {
                const size_t off = (size_t)(row0 + ai * HALF + m * 16) * DM + col0;
#pragma unroll
                for (int bj = 0; bj < 2; ++bj)
#pragma unroll
                    for (int n = 0; n < 2; ++n) {
                        const f32x4 x = *(const f32x4*)(base + off + bj * HALF + 4 * n);
                        *(f32x4*)(Y + off + bj * HALF + 4 * n) = x * ALPHA + gv[bj][n] * acc[ai][bj][m][n];
                    }
            }
    }
};

struct EpiSwiGLU {
    bf16_t* O;
    __device__ __forceinline__ void mid(AccT& acc, const Unit& u, int wr, int wc, int fr, int fq) const {}
    __device__ __forceinline__ void operator()(AccT& acc, const Unit& u, int wr, int wc, int fr, int fq) const {
        const int row0 = u.pm * BM + wr * 64 + fr, col0 = u.pn * 128 + wc * 16 + 4 * fq;
#pragma unroll
        for (int ai = 0; ai < 2; ++ai)
#pragma unroll
            for (int m = 0; m < 4; ++m) {
                bf16_t* rowp = O + (size_t)(row0 + ai * HALF + m * 16) * DFF + col0;
#pragma unroll
                for (int bj = 0; bj < 2; ++bj) {
                    const f32x4 g = acc[ai][bj][m][0], up = acc[ai][bj][m][1];
                    float v[4];
#pragma unroll
                    for (int e = 0; e < 4; ++e) v[e] = g[e] * sigmoidf_(g[e]) * up[e];
                    u32x2 w; w.x = cvt_pk_bf16(v[0], v[1]); w.y = cvt_pk_bf16(v[2], v[3]);
                    *(u32x2*)(rowp + bj * 64) = w;
                }
            }
    }
};

template <class Epi, bool DUAL>
__device__ __forceinline__ void gemm_phase(LAS unsigned char* lds, const Gemm g, const StaticOrder& S, const Epi& E) {
    int tid = threadIdx.x; asm volatile("" : "+v"(tid));
    const int wid = __builtin_amdgcn_readfirstlane(tid >> 6), lane = tid & 63, wr = wid >> 2, wc = wid & 3, fr = lane & 15, fq = lane >> 4;
    const int K = g.K, nt = K / BK;
    unsigned voffA[2], voffB[2];
#pragma unroll
    for (int i = 0; i < 2; ++i) { int R, C; stage_rc(tid * 16 + i * 8192, R, C); const int Rb = (R & ~31) + perm32(R & 31);
        voffA[i] = (unsigned)(R * K + C) * 2u; voffB[i] = (unsigned)(Rb * K + C) * 2u; }
    const size_t kstep = (size_t)(BK * 2);
    const size_t hstep = (size_t)HALF * K * 2;
    const size_t tstep = 2 * hstep;
    const unsigned ldsw = (unsigned)wid * 1024u;
    const int aoff = lds_byte(wr * 64 + fr, fq * 8), boff = lds_byte(wc * 32 + fr, fq * 8);
#define PG8_SA(b, h) (((b) * 2 + (h)) * HTB)
#define PG8_SB(b, h) ((4 + (b) * 2 + (h)) * HTB)
#define PG8_STAGE(bufoff, gbase, voff) do { _Pragma("unroll") for (int _i = 0; _i < 2; ++_i) \
        __builtin_amdgcn_global_load_lds((const unsigned*)((const char*)(gbase) + (voff)[_i]), (LAS unsigned*)(lds + (bufoff) + ldsw + _i * 8192), 16, 0, 0); } while (0)
#define PG8_LDA(dst, b, h) do { _Pragma("unroll") for (int m = 0; m < 4; ++m) _Pragma("unroll") for (int k = 0; k < 2; ++k) dst[m][k] = *(const LAS bf16x8*)(lds + PG8_SA(b, h) + aoff + m * 2048 + k * 1024); } while (0)
#define PG8_LDB(dst, b, h) do { _Pragma("unroll") for (int n = 0; n < 2; ++n) _Pragma("unroll") for (int k = 0; k < 2; ++k) dst[n][k] = *(const LAS bf16x8*)(lds + PG8_SB(b, h) + boff + n * 2048 + k * 1024); } while (0)
#define PG8_MMA(ai, bj, At, Bt) do { __builtin_amdgcn_s_setprio(1); _Pragma("unroll") for (int m = 0; m < 4; ++m) _Pragma("unroll") for (int n = 0; n < 2; ++n) _Pragma("unroll") for (int k = 0; k < 2; ++k) \
        acc[ai][bj][m][n] = __builtin_amdgcn_mfma_f32_16x16x32_bf16(Bt[n][k], At[m][k], acc[ai][bj][m][n], 0, 0, 0); __builtin_amdgcn_s_setprio(0); } while (0)
#define PG8_WAIT_V(n) asm volatile("s_waitcnt vmcnt(" #n ")" ::: "memory")
#define PG8_WAIT_L(n) asm volatile("s_waitcnt lgkmcnt(" #n ")" ::: "memory")
#define PG8_BAR __builtin_amdgcn_s_barrier()
#define PG8_SCHED __builtin_amdgcn_sched_barrier(0)
#define PG8_GETU(ui_, u_, part_, ok_) do { if (DUAL) { ok_ = S.next((ui_) >> 1, u_); part_ = (ui_) & 1; } else { ok_ = S.next((ui_), u_); part_ = 0; } } while (0)
    Unit cur, nxt; int ui = 0, cpart = 0, npart = 0; bool ok;
    PG8_GETU(0, cur, cpart, ok);
    if (!ok) return;
    AccT acc;
#pragma unroll
    for (int a = 0; a < 2; ++a)
#pragma unroll
        for (int b = 0; b < 2; ++b)
#pragma unroll
            for (int m = 0; m < 4; ++m)
#pragma unroll
                for (int n = 0; n < 2; ++n) acc[a][b][m][n] = (f32x4){0.f, 0.f, 0.f, 0.f};
    bf16x8 At[4][2], B0[2][2], B1[2][2];
    const char* cA = (const char*)(cpart ? g.A2 : g.A) + (size_t)cur.pm * tstep; const char* cB = (const char*)(cpart ? g.Bt2 : g.Bt) + (size_t)cur.pn * tstep;
    PG8_STAGE(PG8_SB(0, 0), cB, voffB); PG8_STAGE(PG8_SB(0, 1), cB + hstep, voffB); PG8_STAGE(PG8_SA(0, 0), cA, voffA); PG8_STAGE(PG8_SA(0, 1), cA + hstep, voffA);
    if (wr == 1) PG8_BAR;
    PG8_WAIT_V(2); PG8_BAR;
    PG8_STAGE(PG8_SB(1, 0), cB + kstep, voffB); PG8_STAGE(PG8_SA(1, 0), cA + kstep, voffA); PG8_STAGE(PG8_SB(1, 1), cB + hstep + kstep, voffB);
    PG8_WAIT_V(6); PG8_BAR;
    for (;;) {
        bool has_next; PG8_GETU(ui + 1, nxt, npart, has_next);
        const char* nA = has_next ? (const char*)(npart ? g.A2 : g.A) + (size_t)nxt.pm * tstep : cA; const char* nB = has_next ? (const char*)(npart ? g.Bt2 : g.Bt) + (size_t)nxt.pn * tstep : cB;
        for (int t = 0; t < nt; t += 2) {
            const bool last = (t == nt - 2);
            const char* a1 = cA + (size_t)(t + 1) * kstep;
            const char* a2 = last ? nA : cA + (size_t)(t + 2) * kstep; const char* b2 = last ? nB : cB + (size_t)(t + 2) * kstep;
            const char* a3 = a2 + kstep; const char* b3 = b2 + kstep;
            PG8_LDB(B0, 0, 0); PG8_LDB(B1, 0, 1); PG8_SCHED; PG8_LDA(At, 0, 0); PG8_STAGE(PG8_SA(1, 1), a1 + hstep, voffA);
            PG8_WAIT_V(8); PG8_WAIT_L(0); PG8_BAR; PG8_MMA(0, 0, At, B0); PG8_MMA(0, 1, At, B1); PG8_BAR; PG8_SCHED;
            PG8_LDA(At, 0, 1); PG8_STAGE(PG8_SB(0, 0), b2, voffB); PG8_STAGE(PG8_SB(0, 1), b2 + hstep, voffB); PG8_STAGE(PG8_SA(0, 0), a2, voffA);
            PG8_WAIT_V(8); PG8_WAIT_L(0); PG8_BAR; PG8_MMA(1, 0, At, B0); PG8_MMA(1, 1, At, B1); PG8_BAR; PG8_SCHED;
            PG8_LDB(B0, 1, 0); PG8_LDB(B1, 1, 1); PG8_SCHED; PG8_LDA(At, 1, 0); PG8_STAGE(PG8_SA(0, 1), a2 + hstep, voffA);
            PG8_WAIT_V(8); PG8_WAIT_L(0); PG8_BAR; PG8_MMA(0, 0, At, B0); PG8_MMA(0, 1, At, B1); PG8_BAR; PG8_SCHED;
            PG8_LDA(At, 1, 1); PG8_STAGE(PG8_SB(1, 0), b3, voffB); PG8_STAGE(PG8_SB(1, 1), b3 + hstep, voffB); PG8_STAGE(PG8_SA(1, 0), a3, voffA);
            PG8_WAIT_V(8); PG8_WAIT_L(0); PG8_BAR; PG8_MMA(1, 0, At, B0); PG8_MMA(1, 1, At, B1); PG8_BAR; PG8_SCHED;
        }
        if (wr == 0) PG8_BAR;
        const bool midpart = DUAL && (cpart == 0);
        if (midpart) E.mid(acc, cur, wr, wc, fr, fq); else E(acc, cur, wr, wc, fr, fq);
        if (!has_next) break;
        if (!midpart) {
#pragma unroll
            for (int a = 0; a < 2; ++a)
#pragma unroll
                for (int b = 0; b < 2; ++b)
#pragma unroll
                    for (int m = 0; m < 4; ++m)
#pragma unroll
                        for (int n = 0; n < 2; ++n) acc[a][b][m][n] = (f32x4){0.f, 0.f, 0.f, 0.f};
        }
        cur = nxt; cpart = npart; cA = nA; cB = nB; ++ui;
        if (wr == 1) PG8_BAR;
    }
    PG8_WAIT_V(0);
    PG8_BAR;
#undef PG8_SA
#undef PG8_SB
#undef PG8_STAGE
#undef PG8_LDA
#undef PG8_LDB
#undef PG8_MMA
#undef PG8_WAIT_V
#undef PG8_WAIT_L
#undef PG8_BAR
#undef PG8_SCHED
#undef PG8_GETU
}
}

namespace att {
constexpr int NW = 8, QBLK = 32, KVBLK = 64;
constexpr float SCALE = 0.125f;
constexpr float THR = 8.f;
constexpr int SHM_V = KVBLK * 128 * 2, SHM_K = KVBLK * 128 * 2;
constexpr int LDK = INW;
#define KSWZ(row, colB) ((row) * 256 + ((colB) ^ (((row) & 7) << 4)))
#define SBAR() __builtin_amdgcn_sched_barrier(0)
__device__ __forceinline__ int crow(int r, int hi) { return (r & 3) + 8 * (r >> 2) + 4 * hi; }
__device__ __forceinline__ unsigned cvtpk(float lo, float hi) { unsigned r; asm volatile("v_cvt_pk_bf16_f32 %0, %1, %2" : "=v"(r) : "v"(lo), "v"(hi)); return r; }

__device__ __forceinline__ void partialSM(f32x16& p0, f32x16& p1, float& m_reg, float& mn, float& alpha) {
    constexpr float C = SCALE * 1.4426950408889634f;
    float pmax = p0[0];
#pragma unroll
    for (int r = 1; r < 16; ++r) pmax = fmaxf(pmax, p0[r]);
#pragma unroll
    for (int r = 0; r < 16; ++r) pmax = fmaxf(pmax, p1[r]);
    { auto rr = __builtin_amdgcn_permlane32_swap(__float_as_uint(pmax), __float_as_uint(pmax), false, false);
      pmax = fmaxf(__uint_as_float(rr[0]), __uint_as_float(rr[1])); }
    if (__builtin_expect(__all(pmax - m_reg <= THR / SCALE), 1)) { mn = m_reg; alpha = 1.f; }
    else { mn = fmaxf(m_reg, pmax); alpha = __builtin_amdgcn_exp2f((m_reg - mn) * C); m_reg = mn; }
    float mnC = -mn * C;
#pragma unroll
    for (int r = 0; r < 16; ++r) p0[r] = fmaf(p0[r], C, mnC);
#pragma unroll
    for (int r = 0; r < 16; ++r) p1[r] = fmaf(p1[r], C, mnC);
#pragma unroll
    for (int r = 0; r < 16; ++r) p0[r] = __builtin_amdgcn_exp2f(p0[r]);
}
__device__ __forceinline__ void finishSM(f32x16& p0, f32x16& p1, float alpha, float& l_reg, bf16x8& pa0, bf16x8& pa1, bf16x8& pa2, bf16x8& pa3) {
#pragma unroll
    for (int r = 0; r < 16; ++r) p1[r] = __builtin_amdgcn_exp2f(p1[r]);
    float ps = 0;
#pragma unroll
    for (int r = 0; r < 16; ++r) ps += p0[r];
#pragma unroll
    for (int r = 0; r < 16; ++r) ps += p1[r];
    { auto rr = __builtin_amdgcn_permlane32_swap(__float_as_uint(ps), __float_as_uint(ps), false, false);
      ps = __uint_as_float(rr[0]) + __uint_as_float(rr[1]); }
    l_reg = l_reg * alpha + ps;
#define PK4(P, BASE, OUT) do { unsigned a0 = cvtpk(P[BASE + 0], P[BASE + 1]), a1 = cvtpk(P[BASE + 2], P[BASE + 3]);   \
    unsigned b0 = cvtpk(P[BASE + 4], P[BASE + 5]), b1 = cvtpk(P[BASE + 6], P[BASE + 7]);                              \
    auto r0 = __builtin_amdgcn_permlane32_swap(a0, b0, false, false); auto r1 = __builtin_amdgcn_permlane32_swap(a1, b1, false, false); \
    u32x4 w = {r0[0], r1[0], r0[1], r1[1]}; OUT = *reinterpret_cast<bf16x8*>(&w); } while (0)
    PK4(p0, 0, pa0); PK4(p0, 8, pa1); PK4(p1, 0, pa2); PK4(p1, 8, pa3);
#undef PK4
}
__device__ __forceinline__ void qkt(f32x16& p0, f32x16& p1, const char* Ks, const bf16x8* qr, int r32, int hi, int cofs) {
    p0 = f32x16{}; p1 = f32x16{};
#pragma unroll
    for (int d0 = 0; d0 < 4; ++d0) { int cb = (cofs + d0 * 16 + hi * 8) * 2;
        bf16x8 b0 = *reinterpret_cast<const bf16x8*>(Ks + KSWZ(r32, cb));
        bf16x8 b1 = *reinterpret_cast<const bf16x8*>(Ks + KSWZ(32 + r32, cb));
        p0 = __builtin_amdgcn_mfma_f32_32x32x16_bf16(b0, qr[d0], p0, 0, 0, 0);
        p1 = __builtin_amdgcn_mfma_f32_32x32x16_bf16(b1, qr[d0], p1, 0, 0, 0); }
}
__device__ __forceinline__ int v_st(int k, int c) { const int kk = (k & ~0xC) | ((k & 4) << 1) | ((k & 8) >> 1); return ((kk >> 3) * 4 + (c >> 5)) * 512 + ((kk & 7) * 32 + (c & 31)) * 2; }
__device__ __forceinline__ int v_rd_base(int lane) { return ((lane & 3) << 3) | (((lane >> 2) & 3) << 6) | (((lane >> 4) & 1) << 5) | (((lane >> 5) & 1) << 8); }
constexpr int v_rd_off(int d0, int ks, int half) { return d0 * 512 + ks * 4096 + half * 2048; }
template <int OFF> __device__ __forceinline__ s16x4 tr_read(int vb) {
    s16x4 r; asm volatile("ds_read_b64_tr_b16 %0, %1 offset:%2" : "=&v"(r) : "v"(vb), "i"(OFF) : "memory"); return r;
}
template <int D0> __device__ __forceinline__ void pv_one(f32x16& od, int vb, bf16x8 pa0, bf16x8 pa1, bf16x8 pa2, bf16x8 pa3) {
    const s16x4 l0 = tr_read<v_rd_off(D0, 0, 0)>(vb), h0 = tr_read<v_rd_off(D0, 0, 1)>(vb), l1 = tr_read<v_rd_off(D0, 1, 0)>(vb), h1 = tr_read<v_rd_off(D0, 1, 1)>(vb);
    const s16x4 l2 = tr_read<v_rd_off(D0, 2, 0)>(vb), h2 = tr_read<v_rd_off(D0, 2, 1)>(vb), l3 = tr_read<v_rd_off(D0, 3, 0)>(vb), h3 = tr_read<v_rd_off(D0, 3, 1)>(vb);
    asm volatile("s_waitcnt lgkmcnt(0)" ::: "memory"); SBAR();
#define PK(L, H) (bf16x8){L[0], L[1], L[2], L[3], H[0], H[1], H[2], H[3]}
    od = __builtin_amdgcn_mfma_f32_32x32x16_bf16(pa0, PK(l0, h0), od, 0, 0, 0);
    od = __builtin_amdgcn_mfma_f32_32x32x16_bf16(pa1, PK(l1, h1), od, 0, 0, 0);
    od = __builtin_amdgcn_mfma_f32_32x32x16_bf16(pa2, PK(l2, h2), od, 0, 0, 0);
    od = __builtin_amdgcn_mfma_f32_32x32x16_bf16(pa3, PK(l3, h3), od, 0, 0, 0);
#undef PK
}
__device__ __forceinline__ void pv_d0(f32x16* o, int vb, bf16x8 pa0, bf16x8 pa1, bf16x8 pa2, bf16x8 pa3) {
    pv_one<0>(o[0], vb, pa0, pa1, pa2, pa3); pv_one<1>(o[1], vb, pa0, pa1, pa2, pa3); pv_one<2>(o[2], vb, pa0, pa1, pa2, pa3); pv_one<3>(o[3], vb, pa0, pa1, pa2, pa3);
}

__device__ __forceinline__ void attn_unit(const bf16_t* __restrict__ Qb, const bf16_t* __restrict__ Kh, const bf16_t* __restrict__ Vh,
                                          bf16_t* __restrict__ Ob, int seq, char* lds, float lam, const float* __restrict__ subln_g) {
    int tid = threadIdx.x; asm volatile("" : "+v"(tid));
    const int wid = tid >> 6, lane = tid & 63, r32 = lane & 31, hi = lane >> 5;
    const int cmap = wid >> 2, wq = wid & 3, cofs = cmap * 64;
    char* V_lds = lds; char* K_lds = lds + 2 * SHM_V;
    float* ws = (float*)(lds + 2 * SHM_V + 2 * SHM_K) + wid * 64; float* li_l = ws; float* al_l = ws + 32;
    float m_reg = -1e30f, l_reg = 0; f32x16 o[4] = {}; bf16x8 qr[4];
    const bf16_t* Qw = Qb + (long)(wq * QBLK + r32) * LDK + cofs + hi * 8;
#pragma unroll
    for (int d0 = 0; d0 < 4; ++d0) qr[d0] = *reinterpret_cast<const bf16x8*>(Qw + d0 * 16);
    const int sr = tid >> 4, sc = (tid & 15) * 8, vst0 = v_st(sr, sc), vst1 = v_st(32 + sr, sc);
    const int vb0 = (int)(uintptr_t)V_lds + v_rd_base(lane);
    struct { bf16x8 vs0, vs1, ks0, ks1; } sr_[2];
#define SLOAD(i, k0) do { sr_[i].vs0 = *reinterpret_cast<const bf16x8*>(&Vh[(long)((k0) + sr) * LDK + sc]); sr_[i].vs1 = *reinterpret_cast<const bf16x8*>(&Vh[(long)((k0) + 32 + sr) * LDK + sc]); \
    sr_[i].ks0 = *reinterpret_cast<const bf16x8*>(&Kh[(long)((k0) + sr) * LDK + sc]); sr_[i].ks1 = *reinterpret_cast<const bf16x8*>(&Kh[(long)((k0) + 32 + sr) * LDK + sc]); } while (0)
#define SWRITE(b, i) do { *(bf16x8*)(V_lds + (b) * SHM_V + vst0) = sr_[i].vs0;          \
    *(bf16x8*)(V_lds + (b) * SHM_V + vst1) = sr_[i].vs1; int kc = sc * 2;               \
    *(bf16x8*)(K_lds + (b) * SHM_K + KSWZ(sr, kc)) = sr_[i].ks0;                       \
    *(bf16x8*)(K_lds + (b) * SHM_K + KSWZ(32 + sr, kc)) = sr_[i].ks1; } while (0)
#define SWAIT() asm volatile("s_waitcnt vmcnt(4)" ::: "memory")
#define RESC(a) do { if (__any((a) < 1.f)) { if (hi == 0) al_l[r32] = (a); asm volatile("s_waitcnt lgkmcnt(0)" ::: "memory"); \
    _Pragma("unroll") for (int d = 0; d < 4; ++d) _Pragma("unroll") for (int r = 0; r < 16; ++r) o[d][r] *= al_l[crow(r, hi)]; } } while (0)
    f32x16 pA0, pA1, pB0, pB1; float mnA, mnB, alA, alB; bf16x8 pa0, pa1, pa2, pa3; const int NT = seq / KVBLK;
    constexpr int SE = 0, SO = 1;
    SLOAD(SE, 0); asm volatile("s_waitcnt vmcnt(0)" ::: "memory"); SWRITE(0, SE); __syncthreads();
    qkt(pA0, pA1, K_lds, qr, r32, hi, cofs); partialSM(pA0, pA1, m_reg, mnA, alA);
    SLOAD(SO, KVBLK); if (2 < NT) SLOAD(SE, 2 * KVBLK);
    SWAIT(); SWRITE(1, SO); __syncthreads();
    for (int j = 1; j + 1 < NT; j += 2) {
        SBAR(); qkt(pB0, pB1, K_lds + SHM_K, qr, r32, hi, cofs);
        finishSM(pA0, pA1, alA, l_reg, pa0, pa1, pa2, pa3); SBAR();
        SLOAD(SO, (j + 2) * KVBLK); SBAR();
        pv_d0(o, vb0, pa0, pa1, pa2, pa3); partialSM(pB0, pB1, m_reg, mnB, alB);
        __syncthreads(); SWAIT(); SWRITE(0, SE);
        RESC(alB); __syncthreads();
        SBAR(); qkt(pA0, pA1, K_lds, qr, r32, hi, cofs);
        finishSM(pB0, pB1, alB, l_reg, pa0, pa1, pa2, pa3); SBAR();
        if (j + 3 < NT) SLOAD(SE, (j + 3) * KVBLK); SBAR();
        pv_d0(o, vb0 + (int)SHM_V, pa0, pa1, pa2, pa3); partialSM(pA0, pA1, m_reg, mnA, alA);
        __syncthreads(); SWAIT(); SWRITE(1, SO);
        RESC(alA); __syncthreads();
    }
    SBAR(); qkt(pB0, pB1, K_lds + SHM_K, qr, r32, hi, cofs);
    finishSM(pA0, pA1, alA, l_reg, pa0, pa1, pa2, pa3); SBAR();
    pv_d0(o, vb0, pa0, pa1, pa2, pa3); partialSM(pB0, pB1, m_reg, mnB, alB);
    __syncthreads(); RESC(alB);
    finishSM(pB0, pB1, alB, l_reg, pa0, pa1, pa2, pa3); SBAR();
    pv_d0(o, vb0 + (int)SHM_V, pa0, pa1, pa2, pa3);
    if (hi == 0) li_l[r32] = l_reg; asm volatile("s_waitcnt lgkmcnt(0)" ::: "memory");
    float rli[16];
#pragma unroll
    for (int r = 0; r < 16; ++r) rli[r] = __builtin_amdgcn_rcpf(li_l[crow(r, hi)]);
    __syncthreads();
    float* X = (float*)lds;
    if (cmap == 1) {
#pragma unroll
        for (int d0 = 0; d0 < 4; ++d0)
#pragma unroll
            for (int r = 0; r < 16; ++r) X[((wq * 4 + d0) * 16 + r) * 64 + lane] = o[d0][r] * rli[r];
    }
    __syncthreads();
    if (cmap == 0) {
        float ss[16];
#pragma unroll
        for (int r = 0; r < 16; ++r) { float s = 0.f;
#pragma unroll
            for (int d0 = 0; d0 < 4; ++d0) { const float v = o[d0][r] * rli[r] - lam * X[((wq * 4 + d0) * 16 + r) * 64 + lane]; o[d0][r] = v; s += v * v; }
            ss[r] = s; }
#pragma unroll
        for (int r = 0; r < 16; ++r) {
#pragma unroll
            for (int mk = 1; mk < 32; mk <<= 1) ss[r] += __shfl_xor(ss[r], mk);
            ss[r] = __builtin_amdgcn_rsqf(ss[r] * (1.0f / 128.0f) + 1e-5f);
        }
        float gsc[4];
#pragma unroll
        for (int d0 = 0; d0 < 4; ++d0) gsc[d0] = subln_g[d0 * 32 + r32] * 0.8f;
        bf16_t* Ow = Ob + (long)(wq * QBLK) * DM;
#pragma unroll
        for (int r = 0; r < 16; ++r) { const int orow = crow(r, hi);
#pragma unroll
            for (int d0 = 0; d0 < 4; ++d0) Ow[(long)orow * DM + d0 * 32 + r32] = (bf16_t)f2bf(o[d0][r] * ss[r] * gsc[d0]); }
    }
    __syncthreads();
#undef SLOAD
#undef SWRITE
#undef SWAIT
#undef RESC
}
#undef SBAR
}

template <bool APPLY>
__device__ __forceinline__ void lru_phase(LAS unsigned char* lds, int vcu, int G, int wave, int lane,
                                          const bf16_t* __restrict__ PROJ, bf16_t* __restrict__ REC, const bf16_t* __restrict__ WG,
                                          const float* __restrict__ conv_w, const float* __restrict__ conv_b, const float* __restrict__ b_gates,
                                          const float* __restrict__ lru_lam, f32x2* __restrict__ AGG, const float* __restrict__ CARRY, int S) {
    const int r32 = lane & 31, hi = lane >> 5;
    LAS unsigned char* T = lds + wave * 19456; LAS unsigned char* Y = T + 9792;
    constexpr int ntc = CH / 64, ntask = ntc * 16;
    const int ncs = S / 64;
    for (int task = vcu * 8 + wave; task < ntask; task += G * 8) {
        const int n = task & 15, tc = task >> 4, t0 = tc * 64, cs = tc % ncs, s0 = cs * 64;
#pragma unroll
        for (int i = 0; i < 9; ++i) { const int rr = (lane >> 3) + 8 * i;
            if (rr < 68) { const int sp = s0 - 2 + rr; u32x4 v = (u32x4){0u, 0u, 0u, 0u};
                if (sp >= 0 && sp < S) v = *(const u32x4*)(PROJ + (size_t)(t0 - 2 + rr) * INW + 3072 + n * 64 + (lane & 7) * 8);
                *(LAS u32x4*)(T + rr * 144 + (lane & 7) * 16) = v; } }
        if (APPLY) {
#pragma unroll
            for (int i = 0; i < 8; ++i) { const int rr = (lane >> 3) + 8 * i;
                const u32x4 v = *(const u32x4*)(PROJ + (size_t)(t0 + rr) * INW + 4096 + n * 64 + (lane & 7) * 8);
                *(LAS u32x4*)(Y + rr * 144 + (lane & 7) * 16) = v; }
        }
        {
            float xcv[2][2][16];
#pragma unroll
            for (int tj = 0; tj < 2; ++tj) { const int e = r32 + 32 * tj, ch = n * 64 + e;
                const float w0 = conv_w[ch], w1 = conv_w[1024 + ch], w2 = conv_w[2048 + ch], w3 = conv_w[3072 + ch], cb = conv_b[ch];
#pragma unroll
                for (int ti = 0; ti < 2; ++ti)
#pragma unroll
                    for (int q = 0; q < 4; ++q) { const int tb = 32 * ti + 8 * q + 4 * hi; float raw[7];
#pragma unroll
                        for (int j = 0; j < 7; ++j) raw[j] = bf2f(*(const LAS unsigned short*)(T + (tb + j) * 144 + e * 2));
#pragma unroll
                        for (int k = 0; k < 4; ++k) xcv[tj][ti][4 * q + k] = cb + w0 * raw[k] + w1 * raw[k + 1] + w2 * raw[k + 2] + w3 * raw[k + 3]; }
            }
            asm volatile("s_waitcnt lgkmcnt(0)" ::: "memory");
#pragma unroll
            for (int tj = 0; tj < 2; ++tj) { const int e = r32 + 32 * tj;
#pragma unroll
                for (int ti = 0; ti < 2; ++ti)
#pragma unroll
                    for (int r = 0; r < 16; ++r) { const int tl = 32 * ti + (r & 3) + 8 * (r >> 2) + 4 * hi;
                        *(LAS unsigned short*)(T + tl * 144 + e * 2) = (unsigned short)f2bf(xcv[tj][ti][r]); } }
        }
        asm volatile("s_waitcnt lgkmcnt(0)" ::: "memory");
#pragma unroll 1
        for (int tj = 0; tj < 2; ++tj) {
            const int e = r32 + 32 * tj, ch = n * 64 + e;
            float hs[2][16];
#pragma unroll
            for (int ti = 0; ti < 2; ++ti)
#pragma unroll
                for (int r = 0; r < 16; ++r) hs[ti][r] = 0.f;
#pragma unroll
            for (int dir = 0; dir < 2; ++dir) {
                f32x16 pr[2], pi[2];
                pr[0] = f32x16{}; pr[1] = f32x16{}; pi[0] = f32x16{}; pi[1] = f32x16{};
                const bf16_t* wrp = WG + (size_t)((dir * 2 + 0) * 16 + n) * 4096 + e * 64 + 8 * hi;
                const bf16_t* wip = WG + (size_t)((dir * 2 + 1) * 16 + n) * 4096 + e * 64 + 8 * hi;
                asm volatile("" ::: "memory");
#pragma unroll
                for (int ks = 0; ks < 4; ++ks) {
                    const bf16x8 br = *(const bf16x8*)(wrp + 16 * ks), bi = *(const bf16x8*)(wip + 16 * ks);
#pragma unroll
                    for (int ti = 0; ti < 2; ++ti) {
                        const bf16x8 af = *(const LAS bf16x8*)(T + (r32 + 32 * ti) * 144 + (16 * ks + 8 * hi) * 2);
                        pr[ti] = __builtin_amdgcn_mfma_f32_32x32x16_bf16(af, br, pr[ti], 0, 0, 0);
                        pi[ti] = __builtin_amdgcn_mfma_f32_32x32x16_bf16(af, bi, pi[ti], 0, 0, 0);
                    }
                }
                const float bias_r = b_gates[(dir * 2 + 0) * 1024 + ch], bias_i = b_gates[(dir * 2 + 1) * 1024 + ch];
                const float lamv = lru_lam[dir * 1024 + ch];
                const float z = fast_exp(-lamv);
                const float sp = (z < 0.05f) ? z * (1.0f + z * (-0.5f + z * (0.33333333f + z * (-0.25f + z * 0.2f)))) : __logf(1.0f + z);
                const float cdl2 = -8.0f * sp * LOG2E;
#pragma unroll
                for (int ti = 0; ti < 2; ++ti)
#pragma unroll
                    for (int r = 0; r < 16; ++r) {
                        const float rg = sigmoidf_(pr[ti][r] + bias_r), ig = sigmoidf_(pi[ti][r] + bias_i);
                        const float a = __builtin_amdgcn_exp2f(cdl2 * rg);
                        const float om = fmaf(-a, a, 1.0f);
                        const float xv = bf2f(*(const LAS unsigned short*)(T + (32 * ti + (r & 3) + 8 * (r >> 2) + 4 * hi) * 144 + e * 2));
                        pr[ti][r] = a; pi[ti][r] = __builtin_amdgcn_sqrtf(om) * ig * xv;
                    }
#pragma unroll
                for (int ti = 0; ti < 2; ++ti)
#pragma unroll
                    for (int q = 0; q < 4; ++q) {
                        if (dir == 0) {
#pragma unroll
                            for (int k = 1; k < 4; ++k) { const int ix = 4 * q + k; pi[ti][ix] = fmaf(pr[ti][ix], pi[ti][ix - 1], pi[ti][ix]); pr[ti][ix] = pr[ti][ix] * pr[ti][ix - 1]; }
                        } else {
#pragma unroll
                            for (int k = 2; k >= 0; --k) { const int ix = 4 * q + k; pi[ti][ix] = fmaf(pr[ti][ix], pi[ti][ix + 1], pi[ti][ix]); pr[ti][ix] = pr[ti][ix] * pr[ti][ix + 1]; }
                        }
                    }
                float h = 0.f;
                if (APPLY) h = CARRY[((size_t)(dir * ntc + tc)) * 1024 + ch];
                float hin[8]; float pa = 1.f;
#pragma unroll
                for (int gg = 0; gg < 16; ++gg) {
                    const int g = (dir == 0) ? gg : 15 - gg, j = g >> 1, ti = j >> 2, q = j & 3, cix = (dir == 0) ? 4 * q + 3 : 4 * q;
                    const bool own = ((g & 1) == hi);
                    const float Pc = pr[ti][cix], Lc = pi[ti][cix];
                    const float ho = fmaf(Pc, h, Lc);
                    const float ot = __shfl_xor(ho, 32);
                    if ((g & 1) == ((dir == 0) ? 0 : 1)) hin[j] = h;
                    hin[j] = own ? h : hin[j];
                    h = own ? ho : ot;
                    if ((g & 1) == 0) pa *= Pc;
                }
                if (APPLY) {
#pragma unroll
                    for (int j = 0; j < 8; ++j)
#pragma unroll
                        for (int k = 0; k < 4; ++k) { const int ti = j >> 2, ix = 4 * (j & 3) + k; hs[ti][ix] += fmaf(pr[ti][ix], hin[j], pi[ti][ix]); }
                } else {
                    pa *= __shfl_xor(pa, 32);
                    if (hi == 0) AGG[((size_t)(dir * ntc + tc)) * 1024 + ch] = (f32x2){pa, h};
                }
                __builtin_amdgcn_sched_barrier(0);
            }
            if (APPLY) {
#pragma unroll
                for (int ti = 0; ti < 2; ++ti)
#pragma unroll
                    for (int r = 0; r < 16; ++r) { const int tl = 32 * ti + (r & 3) + 8 * (r >> 2) + 4 * hi;
                        LAS unsigned short* yp = (LAS unsigned short*)(Y + tl * 144 + e * 2);
                        const float yv = bf2f(*yp);
                        const float u = 0.7978845608f * (yv + 0.044715f * yv * yv * yv);
                        const float ge = yv * __builtin_amdgcn_rcpf(1.0f + fast_exp(-2.0f * u));
                        *yp = (unsigned short)f2bf(hs[ti][r] * ge); }
            }
        }
        if (APPLY) {
            asm volatile("s_waitcnt lgkmcnt(0)" ::: "memory");
#pragma unroll
            for (int i = 0; i < 8; ++i) { const int rr = (lane >> 3) + 8 * i;
                const u32x4 v = *(const LAS u32x4*)(Y + rr * 144 + (lane & 7) * 16);
                *(u32x4*)(REC + (size_t)(t0 + rr) * DM + n * 64 + (lane & 7) * 8) = v; }
        }
        asm volatile("s_waitcnt lgkmcnt(0)" ::: "memory");
    }
}

template <int MODE> __device__ __forceinline__ int sigma_col(int g) {
    if (MODE == 1) { if (g >= 2048) return g; const int p = g & 63; return (g & ~63) + 4 * (p >> 3) + (p & 3) + 32 * ((p >> 2) & 1); }
    if (MODE == 2) { const int i = g >> 3, half = (g >> 2) & 1, e = g & 3; return half * DFF + 4 * i + e; }
    return g;
}
template <int MODE>
__device__ __forceinline__ void transpose_item(const float* __restrict__ W, int K, int N, bf16_t* __restrict__ WT, LAS float* scr, int item, int lane) {
    const int nblk = N / 32, kb = item / nblk, nb = item % nblk, k0 = 64 * kb, n0 = 32 * nb;
    const int scol = sigma_col<MODE>(n0 + (lane & 31));
#pragma unroll 8
    for (int i = 0; i < 32; ++i) { const int kk = 2 * i + (lane >> 5); scr[kk * 33 + (lane & 31)] = W[(size_t)(k0 + kk) * N + scol]; }
    asm volatile("s_waitcnt lgkmcnt(0)" ::: "memory");
    const int c = lane & 7;
#pragma unroll
    for (int j = 0; j < 4; ++j) { const int nn = (lane >> 3) + 8 * j; const LAS float* s = scr + (8 * c) * 33 + nn;
        u32x4 o; o.x = f2bf(s[0 * 33]) | (f2bf(s[1 * 33]) << 16); o.y = f2bf(s[2 * 33]) | (f2bf(s[3 * 33]) << 16); o.z = f2bf(s[4 * 33]) | (f2bf(s[5 * 33]) << 16); o.w = f2bf(s[6 * 33]) | (f2bf(s[7 * 33]) << 16);
        *(u32x4*)(WT + (size_t)(n0 + nn) * K + k0 + 8 * c) = o; }
    asm volatile("s_waitcnt lgkmcnt(0)" ::: "memory");
}

#define XB_TMO      128
#define XB_XCNT(j)  (256  + 64 * (j))
#define XB_XSUB(j)  (1280 + 64 * (j))
#define XB_XGEN(j)  (2304 + 64 * (j))
#define XB_TOP      3328
#define XB_TOPGEN   3392
#define XCD_BAR_WORDS 3456
#define XB_SPIN_CAP (1u << 18)

__device__ __forceinline__ unsigned xb_ld(unsigned* p)              { return __hip_atomic_load(p, __ATOMIC_RELAXED, __HIP_MEMORY_SCOPE_AGENT); }
__device__ __forceinline__ unsigned xb_add(unsigned* p, unsigned v) { return __hip_atomic_fetch_add(p, v, __ATOMIC_RELAXED, __HIP_MEMORY_SCOPE_AGENT); }
__device__ __forceinline__ unsigned xb_xcc_id() { return (unsigned)__builtin_amdgcn_s_getreg((3 << 11) | 20) & 0xFu; }
#define XB_SPIN(cond, bar) do { unsigned _sp = 0; while (cond) { __builtin_amdgcn_s_sleep(1); \
    if ((++_sp & 255u) == 0u) { if (xb_ld(&(bar)[XB_TMO])) break; if (_sp > XB_SPIN_CAP) { atomicAdd(&(bar)[XB_TMO], 1u); break; } } } } while (0)

struct XcdBarrier {
    unsigned* bar; unsigned x;
    volatile LAS unsigned* st;
};

__device__ __forceinline__ XcdBarrier xcd_barrier_post(unsigned* bar, volatile LAS unsigned* st) {
    XcdBarrier b; b.bar = bar; b.x = xb_xcc_id(); b.st = st;
    if (threadIdx.x == 0) (void)xb_add(&bar[XB_XCNT(b.x)], 1u);
    return b;
}
__device__ __forceinline__ void xcd_barrier_complete(unsigned* bar, unsigned x, unsigned& nloc, unsigned& nx) {
    const unsigned G = gridDim.x * gridDim.y * gridDim.z;
    unsigned sum, cnt, mine, sp = 0u;
    for (;;) {
        sum = 0u; cnt = 0u; mine = 0u;
#pragma unroll
        for (unsigned j = 0; j < 16; ++j) { const unsigned c = xb_ld(&bar[XB_XCNT(j)]); sum += c; cnt += (c > 0u) ? 1u : 0u; mine = (j == x) ? c : mine; }
        if (sum == G) break;
        __builtin_amdgcn_s_sleep(1);
        if ((++sp & 255u) == 0u) { if (xb_ld(&bar[XB_TMO])) break; if (sp > XB_SPIN_CAP) { atomicAdd(&bar[XB_TMO], 1u); break; } }
    }
    nloc = mine > 0u ? mine : 1u; nx = cnt > 0u ? cnt : 1u;
}

__device__ __forceinline__ void xcd_barrier(const XcdBarrier& b) {
    asm volatile("s_waitcnt vmcnt(0)" ::: "memory");
    __syncthreads();
    if (threadIdx.x == 0) {
        unsigned* bar = b.bar;
        __builtin_amdgcn_s_waitcnt(0);
        unsigned nloc = b.st[0], nx = b.st[1];
        if (nloc == 0u) { xcd_barrier_complete(bar, b.x, nloc, nx); b.st[0] = nloc; b.st[1] = nx; }
        const unsigned old = xb_add(&bar[XB_XSUB(b.x)], 1u);
        const unsigned gen = old / nloc;
        if (old + 1u == (gen + 1u) * nloc) {
            __builtin_amdgcn_fence(__ATOMIC_RELEASE, "agent");
            asm volatile("s_waitcnt vmcnt(0)" ::: "memory");
            const unsigned og = xb_add(&bar[XB_TOP], 1u);
            const unsigned tg = og / nx;
            if (og + 1u == (tg + 1u) * nx) xb_add(&bar[XB_TOPGEN], 1u);
            else XB_SPIN(xb_ld(&bar[XB_TOPGEN]) == tg, bar);
            __builtin_amdgcn_fence(__ATOMIC_ACQUIRE, "agent");
            xb_add(&bar[XB_XGEN(b.x)], 1u);
            asm volatile("s_waitcnt vmcnt(0)" ::: "memory");
        } else {
            XB_SPIN(xb_ld(&bar[XB_XGEN(b.x)]) == gen, bar);
            __builtin_amdgcn_fence(__ATOMIC_ACQUIRE, "agent");
            asm volatile("s_waitcnt vmcnt(0)" ::: "memory");
        }
    }
    __syncthreads();
}

struct KArgs { const float* in[26]; float* out; unsigned char* ws; int ph_lo, ph_hi; };
constexpr int NPP = 11;
constexpr int NPHASE = 2 + NCHUNK * NPP;

__global__ void __launch_bounds__(512, 2) mk_fwd(KArgs a) {
    extern __shared__ __attribute__((aligned(16))) unsigned char lds[];
    cg::grid_group grid = cg::this_grid();
    const int G = gridDim.x, bx = blockIdx.x;
    const int vcu = (G % 8 == 0) ? (bx % 8) * (G / 8) + bx / 8 : bx;
    const int NGW = G * 8;
    LAS unsigned char* ldsl = (LAS unsigned char*)lds;
    volatile LAS unsigned* xst = (volatile LAS unsigned*)(ldsl + LDS_ST_OFF);
    unsigned* barw = (unsigned*)(a.ws + WS_BAR);
    if (threadIdx.x < 16) xst[threadIdx.x] = 0u;
    if (!MK_MULTI && a.ph_lo == 0 && blockIdx.x == 0) for (int u = threadIdx.x; u < XCD_BAR_WORDS; u += 512) __hip_atomic_store(barw + u, 0u, __ATOMIC_RELAXED, __HIP_MEMORY_SCOPE_AGENT);
    __syncthreads();
    XcdBarrier xbar; xbar.bar = barw; xbar.x = 0; xbar.st = xst;
    bool xposted = false;

    for (int it = 2 * a.ph_lo; it < 2 * a.ph_hi; ++it) {
        const int ph = it >> 1, rep = it & 1;
        if (rep && !(ph >= 2 && ((REP_MASK >> ((ph - 2) % NPP)) & 1))) continue;
        size_t zoff = 0; asm volatile("" : "+s"(zoff));
        unsigned char* ws = a.ws + zoff;
        int tid = threadIdx.x; asm volatile("" : "+v"(tid));
        const int lane = tid & 63, wave = __builtin_amdgcn_readfirstlane(tid >> 6), gw = vcu * 8 + wave;
        bf16_t* Win_t = (bf16_t*)(ws + WS_WIN); bf16_t* Wab_t = (bf16_t*)(ws + WS_WAB); bf16_t* Wlb_t = (bf16_t*)(ws + WS_WLB); bf16_t* Wout_t = (bf16_t*)(ws + WS_WOUT);
        bf16_t* Wfi_t = (bf16_t*)(ws + WS_WFI); bf16_t* Wfo_t = (bf16_t*)(ws + WS_WFO); bf16_t* WG = (bf16_t*)(ws + WS_WG);
        float* MODP = (float*)(ws + WS_MODP); float* MOD = (float*)(ws + WS_MOD); float* ROPE = (float*)(ws + WS_ROPE); float* MISC = (float*)(ws + WS_MISC);
        f32x2* AGG = (f32x2*)(ws + WS_AGG); float* CARRY = (float*)(ws + WS_CARRY);
        bf16_t* Hb = (bf16_t*)(ws + WS_H); bf16_t* ATTN = (bf16_t*)(ws + WS_ATTN); bf16_t* REC = (bf16_t*)(ws + WS_REC); bf16_t* MRG = (bf16_t*)(ws + WS_MRG);
        float* X1 = (float*)(ws + WS_X1); bf16_t* PROJ = (bf16_t*)(ws + WS_PROJ); bf16_t* ACT = (bf16_t*)(ws + WS_PROJ);
        const int kk = (ph >= 2) ? (ph - 2) % NPP : -1, chunk = (ph >= 2) ? (ph - 2) / NPP : 0;
        if (it > 2 * a.ph_lo && !(kk == 0 && chunk > 0 && rep == 0)) {
            if (!xposted) { grid.sync(); xbar = xcd_barrier_post(barw, xst); xposted = true; }
            else xcd_barrier(xbar);
        }
        const int row0 = chunk * CH, S = (chunk == 0) ? 4096 : 2048, b0 = batch_of_row(row0);
        const float* xin = (chunk == 0) ? a.in[0] : a.in[1] + (size_t)(row0 - M_P) * DM;
        float* outc = a.out + (size_t)row0 * DM;

        if (ph == 0 && PHON(13)) {
            LAS float* scr = (LAS float*)(ldsl + wave * 16384);
            constexpr int I_IN = (DM / 64) * (INW / 32), I_SQ = (DM / 64) * (DM / 32), I_FI = (DM / 64) * (2 * DFF / 32), I_FO = (DFF / 64) * (DM / 32), I_G = 64 * 2;
            constexpr int NITEMS = I_IN + 3 * I_SQ + I_FI + I_FO + I_G;
            for (int it = gw; it < NITEMS; it += NGW) {
                int r = it;
                if (r < I_IN) { transpose_item<1>(a.in[6], DM, INW, Win_t, scr, r, lane); continue; } r -= I_IN;
                if (r < I_SQ) { transpose_item<0>(a.in[17], DM, DM, Wab_t, scr, r, lane); continue; } r -= I_SQ;
                if (r < I_SQ) { transpose_item<0>(a.in[18], DM, DM, Wlb_t, scr, r, lane); continue; } r -= I_SQ;
                if (r < I_SQ) { transpose_item<0>(a.in[19], DM, DM, Wout_t, scr, r, lane); continue; } r -= I_SQ;
                if (r < I_FI) { transpose_item<2>(a.in[22], DM, 2 * DFF, Wfi_t, scr, r, lane); continue; } r -= I_FI;
                if (r < I_FO) { transpose_item<0>(a.in[23], DFF, DM, Wfo_t, scr, r, lane); continue; } r -= I_FO;
                { const int mat = r >> 1; transpose_item<0>(a.in[14] + (size_t)mat * 4096, 64, 64, WG + (size_t)mat * 4096, scr, r & 1, lane); }
            }
            for (int idx = gw * 64 + lane; idx < 4096 * 32; idx += NGW * 64) {
                const int pos = idx >> 5, i = idx & 31;
                const float inv = __builtin_amdgcn_exp2f(-(float)i * (13.287712379549449f / 32.0f));
                const float ang = (float)pos * inv;
                const double rev = (double)ang * 0.15915494309189535;
                const float fr = (float)(rev - floor(rev));
                ((f32x2*)ROPE)[idx] = (f32x2){__builtin_amdgcn_cosf(fr), __builtin_amdgcn_sinf(fr)};
            }
            if (gw == 0) {
                const float s1 = wave_sum(a.in[7][lane] * a.in[8][lane]), s2 = wave_sum(a.in[9][lane] * a.in[10][lane]);
                if (lane == 0) MISC[0] = fast_exp(s1) - fast_exp(s2) + 0.2f;
            }
            for (int t = gw; t < 96 * 5 * 4; t += NGW) {
                const int kq = t & 3, rg = (t >> 2) % 5, cgp = t / 20, col = cgp * 64 + lane;
                float accm[8];
#pragma unroll
                for (int r = 0; r < 8; ++r) accm[r] = 0.f;
                for (int kb = 0; kb < 4; ++kb) {
                    const int kbase = kq * 256 + kb * 64;
                    float sil[8];
#pragma unroll
                    for (int r = 0; r < 8; ++r) { const int row = rg * 8 + r; const float cv = (row < 8) ? a.in[2][row * DM + kbase + lane] : a.in[3][(row - 8) * DM + kbase + lane]; sil[r] = cv * sigmoidf_(cv); }
#pragma unroll 8
                    for (int j = 0; j < 64; ++j) {
                        const float w = a.in[4][(size_t)(kbase + j) * 6144 + col];
#pragma unroll
                        for (int r = 0; r < 8; ++r) accm[r] = fmaf(__int_as_float(__builtin_amdgcn_readlane(__float_as_int(sil[r]), j)), w, accm[r]);
                    }
                }
#pragma unroll
                for (int r = 0; r < 8; ++r) MODP[((size_t)kq * NMODROWS + rg * 8 + r) * 6144 + col] = accm[r];
            }
        } else if (ph == 1 && PHON(14)) {
            for (int idx = gw * 64 + lane; idx < NMODROWS * 6144; idx += NGW * 64) {
                const int col = idx % 6144;
                MOD[idx] = a.in[5][col] + ((MODP[idx] + MODP[(size_t)NMODROWS * 6144 + idx]) + (MODP[(size_t)2 * NMODROWS * 6144 + idx] + MODP[(size_t)3 * NMODROWS * 6144 + idx]));
            }
        } else if (kk == 0 && PHON(0)) {
            for (int row = 2 * gw; row < CH; row += 2 * NGW) {
                const int b = batch_of_row(row0 + row);
                f32x4 v[2][4]; float s[2], s2[2], mean[2], rstd[2];
#pragma unroll
                for (int u = 0; u < 2; ++u) { const f32x4* xr = (const f32x4*)(xin + (size_t)(row + u) * DM) + lane; s[u] = 0.f;
#pragma unroll
                    for (int j = 0; j < 4; ++j) { v[u][j] = xr[64 * j]; s[u] += (v[u][j].x + v[u][j].y) + (v[u][j].z + v[u][j].w); } }
#pragma unroll
                for (int u = 0; u < 2; ++u) mean[u] = wave_sum(s[u]) * (1.f / DM);
#pragma unroll
                for (int u = 0; u < 2; ++u) { s2[u] = 0.f;
#pragma unroll
                    for (int j = 0; j < 4; ++j) { v[u][j] = v[u][j] - mean[u]; s2[u] += (v[u][j].x * v[u][j].x + v[u][j].y * v[u][j].y) + (v[u][j].z * v[u][j].z + v[u][j].w * v[u][j].w); } }
#pragma unroll
                for (int u = 0; u < 2; ++u) rstd[u] = __builtin_amdgcn_rsqf(wave_sum(s2[u]) * (1.f / DM) + LN_EPS);
                const f32x4* shp = (const f32x4*)(MOD + (size_t)b * 6144) + lane; const f32x4* scp = (const f32x4*)(MOD + (size_t)b * 6144 + 1024) + lane;
#pragma unroll
                for (int j = 0; j < 4; ++j) { const f32x4 sc = scp[64 * j] + 1.0f, sh = shp[64 * j];
#pragma unroll
                    for (int u = 0; u < 2; ++u) { const f32x4 y = v[u][j] * rstd[u] * sc + sh;
                        u32x2 w; w.x = cvt_pk_bf16(y.x, y.y); w.y = cvt_pk_bf16(y.z, y.w); ((u32x2*)(Hb + (size_t)(row + u) * DM) + lane)[64 * j] = w; } }
            }
        } else if (kk == 1 && PHON(1)) {
            pg8::Gemm g{Hb, Win_t, nullptr, nullptr, CH, INW, DM}; pg8::StaticOrder so; so.init(CH, INW, G, bx);
            pg8::EpiProj E{PROJ, (const f32x4*)ROPE, S};
            pg8::gemm_phase<pg8::EpiProj, false>(ldsl, g, so, E);
        } else if (kk == 2 && PHON(2)) {
            lru_phase<false>(ldsl, vcu, G, wave, lane, PROJ, REC, WG, a.in[12], a.in[13], a.in[15], a.in[16], AGG, CARRY, S);
        } else if (kk == 3 && PHON(3)) {
            {
                const int ncs = S / 64, nseq = CH / S, nwt = 2 * nseq * 16;
                for (int t = gw; t < nwt; t += NGW) {
                    const int dir = t / (nseq * 16), sq = (t / 16) % nseq, ch = (t & 15) * 64 + lane;
                    const f32x2* ap = AGG + ((size_t)(dir * (CH / 64) + sq * ncs)) * 1024 + ch;
                    float* cp = CARRY + ((size_t)(dir * (CH / 64) + sq * ncs)) * 1024 + ch;
                    float h = 0.f;
                    for (int c0 = 0; c0 < ncs; c0 += 8) {
                        f32x2 ab[8];
#pragma unroll
                        for (int i = 0; i < 8; ++i) { const int c = (dir == 0) ? c0 + i : ncs - 1 - c0 - i; ab[i] = ap[(size_t)c * 1024]; }
#pragma unroll
                        for (int i = 0; i < 8; ++i) { const int c = (dir == 0) ? c0 + i : ncs - 1 - c0 - i; cp[(size_t)c * 1024] = h; h = fmaf(ab[i].x, h, ab[i].y); }
                    }
                }
            }
            const float lam = MISC[0];
            const int nqb = S / 128, nunits = (CH / S) * 8 * nqb;
            for (int i = 0;; ++i) {
                const int unit = i * G + vcu; if (unit >= nunits) break;
                const int bh = unit / nqb, qb = unit % nqb, b = bh >> 3, h = bh & 7;
                const size_t rowbase = (size_t)b * S;
                att::attn_unit(PROJ + (rowbase + (size_t)qb * 128) * INW + h * 128, PROJ + rowbase * INW + 1024 + h * 128, PROJ + rowbase * INW + 2048 + h * 128,
                               ATTN + (rowbase + (size_t)qb * 128) * DM + h * 128, S, (char*)lds, lam, a.in[11]);
            }
        } else if (kk == 4 && PHON(4)) {
            lru_phase<true>(ldsl, vcu, G, wave, lane, PROJ, REC, WG, a.in[12], a.in[13], a.in[15], a.in[16], AGG, CARRY, S);
        } else if (kk == 5 && PHON(5)) {
            pg8::Gemm g{ATTN, Wab_t, REC, Wlb_t, CH, DM, DM}; pg8::StaticOrder so; so.init(CH, DM, G, bx);
            pg8::EpiMerge E{MRG, PROJ};
            pg8::gemm_phase<pg8::EpiMerge, true>(ldsl, g, so, E);
        } else if (kk == 6 && PHON(6)) {
            pg8::Gemm g{MRG, Wout_t, nullptr, nullptr, CH, DM, DM}; pg8::StaticOrder so; so.init(CH, DM, G, bx);
            pg8::EpiRes E{xin, outc, MOD + 2048, S, b0};
            pg8::gemm_phase<pg8::EpiRes, false>(ldsl, g, so, E);
        } else if (kk == 7 && PHON(7)) {
            for (int row = 2 * gw; row < CH; row += 2 * NGW) {
                const int b = batch_of_row(row0 + row);
                f32x4 v[2][4]; float s[2], s2[2], mean[2], rstd[2];
#pragma unroll
                for (int u = 0; u < 2; ++u) { const f32x4* yr = (const f32x4*)(outc + (size_t)(row + u) * DM) + lane; s[u] = 0.f;
#pragma unroll
                    for (int j = 0; j < 4; ++j) { v[u][j] = yr[64 * j]; s[u] += (v[u][j].x + v[u][j].y) + (v[u][j].z + v[u][j].w); } }
#pragma unroll
                for (int u = 0; u < 2; ++u) mean[u] = wave_sum(s[u]) * (1.f / DM);
#pragma unroll
                for (int u = 0; u < 2; ++u) { s2[u] = 0.f;
#pragma unroll
                    for (int j = 0; j < 4; ++j) { v[u][j] = v[u][j] - mean[u]; s2[u] += (v[u][j].x * v[u][j].x + v[u][j].y * v[u][j].y) + (v[u][j].z * v[u][j].z + v[u][j].w * v[u][j].w); } }
#pragma unroll
                for (int u = 0; u < 2; ++u) { rstd[u] = __builtin_amdgcn_rsqf(wave_sum(s2[u]) * (1.f / DM) + LN_EPS); s[u] = 0.f; }
#pragma unroll
                for (int j = 0; j < 4; ++j) { const f32x4 gg = ((const f32x4*)a.in[20])[lane + 64 * j], bb = ((const f32x4*)a.in[21])[lane + 64 * j];
#pragma unroll
                    for (int u = 0; u < 2; ++u) { v[u][j] = v[u][j] * rstd[u] * gg + bb; ((f32x4*)(X1 + (size_t)(row + u) * DM) + lane)[64 * j] = v[u][j]; s[u] += (v[u][j].x + v[u][j].y) + (v[u][j].z + v[u][j].w); } }
#pragma unroll
                for (int u = 0; u < 2; ++u) mean[u] = wave_sum(s[u]) * (1.f / DM);
#pragma unroll
                for (int u = 0; u < 2; ++u) { s2[u] = 0.f;
#pragma unroll
                    for (int j = 0; j < 4; ++j) { v[u][j] = v[u][j] - mean[u]; s2[u] += (v[u][j].x * v[u][j].x + v[u][j].y * v[u][j].y) + (v[u][j].z * v[u][j].z + v[u][j].w * v[u][j].w); } }
#pragma unroll
                for (int u = 0; u < 2; ++u) rstd[u] = __builtin_amdgcn_rsqf(wave_sum(s2[u]) * (1.f / DM) + LN_EPS);
                const f32x4* shp = (const f32x4*)(MOD + (size_t)b * 6144 + 3072) + lane; const f32x4* scp = (const f32x4*)(MOD + (size_t)b * 6144 + 4096) + lane;
#pragma unroll
                for (int j = 0; j < 4; ++j) { const f32x4 sc = scp[64 * j] + 1.0f, sh = shp[64 * j];
#pragma unroll
                    for (int u = 0; u < 2; ++u) { const f32x4 y = v[u][j] * rstd[u] * sc + sh;
                        u32x2 w; w.x = cvt_pk_bf16(y.x, y.y); w.y = cvt_pk_bf16(y.z, y.w); ((u32x2*)(Hb + (size_t)(row + u) * DM) + lane)[64 * j] = w; } }
            }
        } else if (kk == 8 && PHON(8)) {
            pg8::Gemm g{Hb, Wfi_t, nullptr, nullptr, CH, 2 * DFF, DM}; pg8::StaticOrder so; so.init(CH, 2 * DFF, G, bx);
            pg8::EpiSwiGLU E{ACT};
            pg8::gemm_phase<pg8::EpiSwiGLU, false>(ldsl, g, so, E);
        } else if (kk == 9 && PHON(9)) {
            pg8::Gemm g{ACT, Wfo_t, nullptr, nullptr, CH, DM, DFF}; pg8::StaticOrder so; so.init(CH, DM, G, bx);
            pg8::EpiRes E{X1, outc, MOD + 5120, S, b0};
            pg8::gemm_phase<pg8::EpiRes, false>(ldsl, g, so, E);
        } else if (kk == 10 && PHON(10)) {
            for (int row = 2 * gw; row < CH; row += 2 * NGW) {
                f32x4 v[2][4]; float s[2], s2[2], mean[2], rstd[2];
#pragma unroll
                for (int u = 0; u < 2; ++u) { const f32x4* yr = (const f32x4*)(outc + (size_t)(row + u) * DM) + lane; s[u] = 0.f;
#pragma unroll
                    for (int j = 0; j < 4; ++j) { v[u][j] = yr[64 * j]; s[u] += (v[u][j].x + v[u][j].y) + (v[u][j].z + v[u][j].w); } }
#pragma unroll
                for (int u = 0; u < 2; ++u) mean[u] = wave_sum(s[u]) * (1.f / DM);
#pragma unroll
                for (int u = 0; u < 2; ++u) { s2[u] = 0.f;
#pragma unroll
                    for (int j = 0; j < 4; ++j) { v[u][j] = v[u][j] - mean[u]; s2[u] += (v[u][j].x * v[u][j].x + v[u][j].y * v[u][j].y) + (v[u][j].z * v[u][j].z + v[u][j].w * v[u][j].w); } }
#pragma unroll
                for (int u = 0; u < 2; ++u) rstd[u] = __builtin_amdgcn_rsqf(wave_sum(s2[u]) * (1.f / DM) + LN_EPS);
#pragma unroll
                for (int j = 0; j < 4; ++j) { const f32x4 gg = ((const f32x4*)a.in[24])[lane + 64 * j], bb = ((const f32x4*)a.in[25])[lane + 64 * j];
#pragma unroll
                    for (int u = 0; u < 2; ++u) ((f32x4*)(outc + (size_t)(row + u) * DM) + lane)[64 * j] = v[u][j] * rstd[u] * gg + bb; }
            }
        }
    }
}

extern "C" void kernel_launch(void* const* d_in, const int* in_sizes, int n_in, void* d_out, int out_size, void* d_ws, size_t ws_size, hipStream_t stream) {
    static int grid = 0;
    if (grid == 0) {
        if (n_in != 26 || out_size != M_ALL * DM || ws_size < WS_END) { fprintf(stderr, "kernel_launch: unexpected shapes n_in %d out %d ws %zu (need %zu)\n", n_in, out_size, ws_size, (size_t)WS_END); grid = -1; return; }
        int dev = 0, cus = 0, per_cu = 0;
        hipGetDevice(&dev); hipDeviceGetAttribute(&cus, hipDeviceAttributeMultiprocessorCount, dev);
        if (hipFuncSetAttribute((const void*)mk_fwd, hipFuncAttributeMaxDynamicSharedMemorySize, LDS_BYTES) != hipSuccess) { fprintf(stderr, "kernel_launch: hipFuncSetAttribute failed\n"); grid = -1; return; }
        hipOccupancyMaxActiveBlocksPerMultiprocessor(&per_cu, (const void*)mk_fwd, 512, LDS_BYTES);
        (void)hipGetLastError();
        if (per_cu < 1) fprintf(stderr, "kernel_launch: occupancy query says %d blocks/CU\n", per_cu);
        grid = cus;
    }
    if (grid < 0) return;
    KArgs a{};
    for (int i = 0; i < 26; ++i) a.in[i] = (const float*)d_in[i];
    a.out = (float*)d_out; a.ws = (unsigned char*)d_ws;
#if MK_MULTI
    for (int ph = 0; ph < NPHASE; ++ph) { a.ph_lo = ph; a.ph_hi = ph + 1; hipLaunchKernelGGL(mk_fwd, dim3(grid), dim3(512), LDS_BYTES, stream, a); }
#else
    a.ph_lo = 0; a.ph_hi = NPHASE;
    void* args[] = {&a};
    hipError_t e = hipLaunchCooperativeKernel((void*)mk_fwd, dim3(grid), dim3(512), args, LDS_BYTES, stream);
    if (e != hipSuccess) fprintf(stderr, "cooperative launch failed: %s (grid %d)\n", hipGetErrorString(e), grid);
#endif
}
```
